# Optimizing an MI355X kernel written in HIP

```python
import jax
import jax.numpy as jnp
from jax import lax
import numpy as np

D_MODEL = 2048
BATCH = 4
SEQ = 4096
DEPTH = 2

GRID_W = 64
CTX_LEN = 256
HEAD_DIM = 128
BLOCK = 128
NA_HEADS = 4
NA_WIN_R = 8
NA_WIN_C = 16
SWA_HEADS = 4
SWA_KV_HEADS = 2
SWA_WINDOW = 128
MLA_HEADS = 4
MLA_Q_LORA = 384
MLA_KV_LORA = 128
MLA_NOPE = 128
MLA_ROPE = 64
MLA_V = 128
GQA_HEADS = 4
GQA_KV_HEADS = 2
MIX_WIDTH = (NA_HEADS + SWA_HEADS + GQA_HEADS) * HEAD_DIM + MLA_HEADS * MLA_V
D_FF = 5632
CONV_W = 3
ROPE_THETA = 10000.0
EPS = 1e-6
NEG = -1e30
DEEPNORM_ALPHA = (2 * DEPTH) ** 0.25
DEEPNORM_BETA = (8 * DEPTH) ** -0.25
IN_SIZES = (
    NA_HEADS * HEAD_DIM, NA_HEADS * HEAD_DIM, NA_HEADS * HEAD_DIM,
    SWA_HEADS * HEAD_DIM, SWA_KV_HEADS * HEAD_DIM, SWA_KV_HEADS * HEAD_DIM,
    MLA_Q_LORA, MLA_KV_LORA, MLA_ROPE,
    GQA_HEADS * HEAD_DIM, GQA_KV_HEADS * HEAD_DIM, GQA_KV_HEADS * HEAD_DIM,
)
IN_COLS = sum(IN_SIZES)

kernel_name = 'hybrid_dit_parallel_heads_deepnorm'


def layer_norm(x, g=None, b=None):
    xf = x.astype(jnp.float32)
    mu = jnp.mean(xf, axis=-1, keepdims=True)
    var = jnp.mean(jnp.square(xf - mu), axis=-1, keepdims=True)
    y = (xf - mu) * lax.rsqrt(var + EPS)
    if g is not None:
        y = y * g + b
    return y.astype(x.dtype)


def rms_norm(x, g):
    xf = x.astype(jnp.float32)
    y = xf * lax.rsqrt(jnp.mean(xf * xf, axis=-1, keepdims=True) + EPS) * g
    return y.astype(x.dtype)


def modulate(x, shift, scale):
    return layer_norm(x) * (1 + scale) + shift


def rope_1d(x, pos):
    half = x.shape[-1] // 2
    inv_freq = ROPE_THETA ** (-jnp.arange(half, dtype=jnp.float32) / half)
    ang = pos.astype(jnp.float32)[:, None] * inv_freq[None, :]
    cos, sin = jnp.cos(ang), jnp.sin(ang)
    xf = x.astype(jnp.float32)
    x1, x2 = xf[..., :half], xf[..., half:]
    return jnp.concatenate([x1 * cos - x2 * sin, x2 * cos + x1 * sin], axis=-1).astype(x.dtype)


def rope_2d(x, row, col):
    h = x.shape[-1] // 2
    return jnp.concatenate([rope_1d(x[..., :h], row), rope_1d(x[..., h:], col)], axis=-1)


def split_cols(p):
    out, o = [], 0
    for n in IN_SIZES:
        out.append(p[..., o:o + n])
        o += n
    return out


def to_heads(t, n):
    B, S, _ = t.shape
    return t.reshape(B, S, n, -1).transpose(0, 2, 1, 3)


def from_heads(o):
    B, n, S, d = o.shape
    return o.transpose(0, 2, 1, 3).reshape(B, S, n * d)


def full_attention(q, k, v, scale, sink=None):
    s = jnp.einsum('bhgqd,bhkd->bhgqk', q, k, preferred_element_type=jnp.float32) * scale
    if sink is not None:
        s_sink = jnp.broadcast_to(sink.astype(jnp.float32)[None, :, :, None, None], s.shape[:-1] + (1,))
        s = jnp.concatenate([s, s_sink], axis=-1)
    p = jax.nn.softmax(s, axis=-1)[..., :k.shape[2]]
    return jnp.einsum('bhgqk,bhkd->bhgqd', p.astype(v.dtype), v)


def mixer_neighbourhood(px, pc, rpb, need_ctx):
    q, k, v = (to_heads(t, NA_HEADS) for t in px)
    kc, vc = to_heads(pc[1], NA_HEADS), to_heads(pc[2], NA_HEADS)
    scale = HEAD_DIM ** -0.5
    B, H, S, d = q.shape
    rows = S // GRID_W
    wr = min(NA_WIN_R, rows)
    qg = q.reshape(B, H, rows, GRID_W, d)
    kg = k.reshape(B, H, rows, GRID_W, d)
    vg = v.reshape(B, H, rows, GRID_W, d)
    r = jnp.arange(rows)
    r0 = jnp.clip(r - wr // 2, 0, rows - wr)
    krow = r0[:, None] + jnp.arange(wr)[None, :]
    k_band = kg[:, :, krow]
    v_band = vg[:, :, krow]
    cq = jnp.arange(GRID_W)
    c0 = jnp.clip(cq - NA_WIN_C // 2, 0, GRID_W - NA_WIN_C)
    col_in = (cq[None, :] >= c0[:, None]) & (cq[None, :] < c0[:, None] + NA_WIN_C)
    drow_idx = krow - r[:, None] + NA_WIN_R - 1
    dcol_idx = jnp.clip(cq[None, :] - cq[:, None] + NA_WIN_C - 1, 0, 2 * NA_WIN_C - 2)
    bias = rpb[:, drow_idx[:, None, :, None], dcol_idx[None, :, None, :]]
    s = jnp.einsum('bhrqd,bhrwkd->bhrqwk', qg, k_band, preferred_element_type=jnp.float32) * scale
    s = jnp.where(col_in[:, None, :], s + bias[None], NEG)
    nwin = wr * GRID_W
    s = s.reshape(B, H, rows, GRID_W, nwin)
    s_ctx = jnp.einsum('bhrqd,bhcd->bhrqc', qg, kc, preferred_element_type=jnp.float32) * scale
    p = jax.nn.softmax(jnp.concatenate([s, s_ctx], axis=-1), axis=-1)
    o = (jnp.einsum('bhrqn,bhrnd->bhrqd', p[..., :nwin].astype(v.dtype), v_band.reshape(B, H, rows, nwin, d))
         + jnp.einsum('bhrqc,bhcd->bhrqd', p[..., nwin:].astype(v.dtype), vc))
    out_x = from_heads(o.reshape(B, H, S, d))
    out_c = None
    if need_ctx:
        qc = to_heads(pc[0], NA_HEADS)
        out_c = from_heads(full_attention(qc[:, :, None], kc, vc, scale)[:, :, 0])
    return out_x, out_c


def mixer_sliding(px, pc, row, col, sink, need_ctx):
    G = SWA_HEADS // SWA_KV_HEADS
    q = rope_2d(to_heads(px[0], SWA_HEADS), row, col)
    k = rope_2d(to_heads(px[1], SWA_KV_HEADS), row, col)
    v = to_heads(px[2], SWA_KV_HEADS)
    kc, vc = to_heads(pc[1], SWA_KV_HEADS), to_heads(pc[2], SWA_KV_HEADS)
    sink = sink.reshape(SWA_KV_HEADS, G)
    scale = HEAD_DIM ** -0.5
    B, _, S, d = q.shape
    nb = S // BLOCK
    qb = q.reshape(B, SWA_KV_HEADS, G, nb, BLOCK, d)
    pad = ((0, 0), (0, 0), (BLOCK, BLOCK), (0, 0))
    idx = jnp.arange(nb)[:, None] * BLOCK + jnp.arange(3 * BLOCK)[None, :]
    kb = jnp.pad(k, pad)[:, :, idx]
    vb = jnp.pad(v, pad)[:, :, idx]
    kpos = idx - BLOCK
    qpos = jnp.arange(S).reshape(nb, BLOCK)
    valid = ((jnp.abs(kpos[:, None, :] - qpos[:, :, None]) <= SWA_WINDOW)
             & (kpos >= 0)[:, None, :] & (kpos < S)[:, None, :])
    s = jnp.einsum('bhgnqd,bhnkd->bhgnqk', qb, kb, preferred_element_type=jnp.float32) * scale
    s = jnp.where(valid, s, NEG)
    s_ctx = jnp.einsum('bhgnqd,bhcd->bhgnqc', qb, kc, preferred_element_type=jnp.float32) * scale
    s_sink = jnp.broadcast_to(sink.astype(jnp.float32)[None, :, :, None, None, None], s.shape[:-1] + (1,))
    p = jax.nn.softmax(jnp.concatenate([s, s_ctx, s_sink], axis=-1), axis=-1)
    nk, C = 3 * BLOCK, kc.shape[2]
    o = (jnp.einsum('bhgnqk,bhnkd->bhgnqd', p[..., :nk].astype(v.dtype), vb)
         + jnp.einsum('bhgnqc,bhcd->bhgnqd', p[..., nk:nk + C].astype(v.dtype), vc))
    out_x = from_heads(o.reshape(B, SWA_HEADS, S, d))
    out_c = None
    if need_ctx:
        qc = to_heads(pc[0], SWA_HEADS)
        qc = qc.reshape(B, SWA_KV_HEADS, G, qc.shape[2], d)
        oc = full_attention(qc, kc, vc, scale, sink)
        out_c = from_heads(oc.reshape(B, SWA_HEADS, qc.shape[3], d))
    return out_x, out_c


def mixer_mla(px, pc, row, col, q_norm, kv_norm, w_uq, w_ukv, need_ctx):
    def proj_q(cq):
        qh = to_heads(rms_norm(cq, q_norm) @ w_uq, MLA_HEADS)
        return qh[..., :MLA_NOPE], qh[..., MLA_NOPE:]

    def proj_kv(ckv):
        kvh = to_heads(rms_norm(ckv, kv_norm) @ w_ukv, MLA_HEADS)
        return kvh[..., :MLA_NOPE], kvh[..., MLA_NOPE:]

    scale = (MLA_NOPE + MLA_ROPE) ** -0.5

    def attend(qn, qpe, kn, kpe, v):
        s = (jnp.einsum('bhqd,bhkd->bhqk', qn, kn, preferred_element_type=jnp.float32)
             + jnp.einsum('bhqr,bkr->bhqk', qpe, kpe, preferred_element_type=jnp.float32)) * scale
        p = jax.nn.softmax(s, axis=-1)
        return jnp.einsum('bhqk,bhkd->bhqd', p.astype(v.dtype), v)

    qn, qpe = proj_q(px[0])
    qpe = rope_2d(qpe, row, col)
    kn, v = proj_kv(px[1])
    kpe = rope_2d(px[2], row, col)
    kn_c, v_c = proj_kv(pc[1])
    kpe_c = pc[2]
    kn_all = jnp.concatenate([kn, kn_c], axis=2)
    kpe_all = jnp.concatenate([kpe, kpe_c], axis=1)
    v_all = jnp.concatenate([v, v_c], axis=2)
    B, H, S, _ = qn.shape
    nb = S // BLOCK
    blocks = lambda t: jnp.moveaxis(t.reshape(B, H, nb, BLOCK, t.shape[-1]), 2, 0)
    o = lax.map(lambda qs: attend(qs[0], qs[1], kn_all, kpe_all, v_all), (blocks(qn), blocks(qpe)))
    out_x = from_heads(jnp.moveaxis(o, 0, 2).reshape(B, H, S, MLA_V))
    out_c = None
    if need_ctx:
        qn_c, qpe_c = proj_q(pc[0])
        out_c = from_heads(attend(qn_c, qpe_c, kn_c, kpe_c, v_c))
    return out_x, out_c


def mixer_gqa(px, pc, row, col, q_norm, k_norm, need_ctx):
    G = GQA_HEADS // GQA_KV_HEADS
    q = rope_2d(rms_norm(to_heads(px[0], GQA_HEADS), q_norm), row, col)
    k = rope_2d(rms_norm(to_heads(px[1], GQA_KV_HEADS), k_norm), row, col)
    v = to_heads(px[2], GQA_KV_HEADS)
    kc = rms_norm(to_heads(pc[1], GQA_KV_HEADS), k_norm)
    vc = to_heads(pc[2], GQA_KV_HEADS)
    k_all = jnp.concatenate([k, kc], axis=2)
    v_all = jnp.concatenate([v, vc], axis=2)
    scale = HEAD_DIM ** -0.5
    B, _, S, d = q.shape
    nb = S // BLOCK
    qb = jnp.moveaxis(q.reshape(B, GQA_KV_HEADS, G, nb, BLOCK, d), 3, 0)
    o = lax.map(lambda qi: full_attention(qi, k_all, v_all, scale), qb)
    out_x = from_heads(jnp.moveaxis(o, 0, 3).reshape(B, GQA_HEADS, S, d))
    out_c = None
    if need_ctx:
        qc = rms_norm(to_heads(pc[0], GQA_HEADS), q_norm)
        C = qc.shape[2]
        oc = full_attention(qc.reshape(B, GQA_KV_HEADS, G, C, d), kc, vc, scale)
        out_c = from_heads(oc.reshape(B, GQA_HEADS, C, d))
    return out_x, out_c


def depthwise_conv(h, w, b):
    S = h.shape[1]
    hp = jnp.pad(h, ((0, 0), (CONV_W // 2, CONV_W // 2), (0, 0)))
    return hp[:, 0:S] * w[0] + hp[:, 1:S + 1] * w[1] + hp[:, 2:S + 2] * w[2] + b


def conv_ffn(h, w_gate, w_up, conv_w, conv_b, w_down):
    a = depthwise_conv(h @ w_gate, conv_w, conv_b)
    return (jax.nn.silu(a) * (h @ w_up)) @ w_down


def setup_inputs(seed: int = 0) -> dict:
    key = jax.random.key(seed)
    ks = jax.random.split(key, 25)
    L, D = DEPTH, D_MODEL

    def nrm(k, shape, s):
        return jax.random.normal(k, shape, jnp.float32) * s

    return {
        'x': nrm(ks[0], (BATCH, SEQ, D), 1.0),
        'c': nrm(ks[1], (BATCH, D), 1.0),
        'ctx': nrm(ks[2], (BATCH, CTX_LEN, D), 1.0),
        'c_ctx': nrm(ks[3], (D,), 1.0),
        'w_ada': nrm(ks[4], (L, D, 6 * D), D ** -0.5),
        'b_ada': nrm(ks[5], (L, 6 * D), 0.02),
        'w_in': nrm(ks[6], (L, D, IN_COLS), D ** -0.5),
        'na_rpb': nrm(ks[7], (L, NA_HEADS, 2 * NA_WIN_R - 1, 2 * NA_WIN_C - 1), 0.5),
        'swa_sink': nrm(ks[8], (L, SWA_HEADS), 0.5),
        'mla_q_norm': 1.0 + nrm(ks[9], (L, MLA_Q_LORA), 0.05),
        'mla_kv_norm': 1.0 + nrm(ks[10], (L, MLA_KV_LORA), 0.05),
        'mla_w_uq': nrm(ks[11], (L, MLA_Q_LORA, MLA_HEADS * (MLA_NOPE + MLA_ROPE)), MLA_Q_LORA ** -0.5),
        'mla_w_ukv': nrm(ks[12], (L, MLA_KV_LORA, MLA_HEADS * (MLA_NOPE + MLA_V)), MLA_KV_LORA ** -0.5),
        'gqa_q_norm': 1.0 + nrm(ks[13], (L, HEAD_DIM), 0.05),
        'gqa_k_norm': 1.0 + nrm(ks[14], (L, HEAD_DIM), 0.05),
        'w_out': nrm(ks[15], (L, MIX_WIDTH, D), DEEPNORM_BETA * MIX_WIDTH ** -0.5),
        'ln1_g': 1.0 + nrm(ks[16], (L, D), 0.05),
        'ln1_b': nrm(ks[17], (L, D), 0.02),
        'ffn_w_gate': nrm(ks[18], (L, D, D_FF), D ** -0.5),
        'ffn_w_up': nrm(ks[19], (L, D, D_FF), D ** -0.5),
        'ffn_conv_w': nrm(ks[20], (L, CONV_W, D_FF), CONV_W ** -0.5),
        'ffn_conv_b': nrm(ks[21], (L, D_FF), 0.02),
        'ffn_w_down': nrm(ks[22], (L, D_FF, D), DEEPNORM_BETA * D_FF ** -0.5),
        'ln2_g': 1.0 + nrm(ks[23], (L, D), 0.05),
        'ln2_b': nrm(ks[24], (L, D), 0.02),
    }


def reference(x, c, ctx, c_ctx, w_ada, b_ada, w_in, na_rpb, swa_sink, mla_q_norm, mla_kv_norm,
              mla_w_uq, mla_w_ukv, gqa_q_norm, gqa_k_norm, w_out, ln1_g, ln1_b,
              ffn_w_gate, ffn_w_up, ffn_conv_w, ffn_conv_b, ffn_w_down, ln2_g, ln2_b):
    t = jnp.arange(x.shape[1])
    row, col = t // GRID_W, t % GRID_W
    for i in range(DEPTH):
        need_ctx = i < DEPTH - 1
        mod_x = jnp.split((jax.nn.silu(c) @ w_ada[i] + b_ada[i])[:, None, :], 6, axis=-1)
        mod_c = jnp.split(jax.nn.silu(c_ctx) @ w_ada[i] + b_ada[i], 6, axis=-1)

        px = split_cols(modulate(x, mod_x[0], mod_x[1]) @ w_in[i])
        pc = split_cols(modulate(ctx, mod_c[0], mod_c[1]) @ w_in[i])
        oa_x, oa_c = mixer_neighbourhood(px[0:3], pc[0:3], na_rpb[i], need_ctx)
        ob_x, ob_c = mixer_sliding(px[3:6], pc[3:6], row, col, swa_sink[i], need_ctx)
        oc_x, oc_c = mixer_mla(px[6:9], pc[6:9], row, col, mla_q_norm[i], mla_kv_norm[i],
                               mla_w_uq[i], mla_w_ukv[i], need_ctx)
        od_x, od_c = mixer_gqa(px[9:12], pc[9:12], row, col, gqa_q_norm[i], gqa_k_norm[i], need_ctx)
        mix_x = jnp.concatenate([oa_x, ob_x, oc_x, od_x], axis=-1)
        x = layer_norm(DEEPNORM_ALPHA * x + mod_x[2] * (mix_x @ w_out[i]), ln1_g[i], ln1_b[i])
        if need_ctx:
            mix_c = jnp.concatenate([oa_c, ob_c, oc_c, od_c], axis=-1)
            ctx = layer_norm(DEEPNORM_ALPHA * ctx + mod_c[2] * (mix_c @ w_out[i]), ln1_g[i], ln1_b[i])

        ffn_args = (ffn_w_gate[i], ffn_w_up[i], ffn_conv_w[i], ffn_conv_b[i], ffn_w_down[i])
        x = layer_norm(DEEPNORM_ALPHA * x + mod_x[5] * conv_ffn(modulate(x, mod_x[3], mod_x[4]), *ffn_args),
                       ln2_g[i], ln2_b[i])
        if need_ctx:
            ctx = layer_norm(DEEPNORM_ALPHA * ctx + mod_c[5] * conv_ffn(modulate(ctx, mod_c[3], mod_c[4]), *ffn_args),
                             ln2_g[i], ln2_b[i])
    return x
```

```cpp
#include <hip/hip_runtime.h>
#include <hip/hip_cooperative_groups.h>
#include <cstdio>
#include <cstdint>
namespace cg = cooperative_groups;

__device__ __forceinline__ int lane_id_() { int r; asm volatile("v_mbcnt_lo_u32_b32 %0, -1, 0\n\tv_mbcnt_hi_u32_b32 %0, -1, %0" : "=v"(r)); return r; }

__device__ __forceinline__ float bperm_(int srclane, float v) { return __builtin_bit_cast(float, __builtin_amdgcn_ds_bpermute(srclane << 2, __builtin_bit_cast(int, v))); }

namespace pg8 {
#define PG8_LAS __attribute__((address_space(3)))
typedef unsigned short bf16_t;
typedef short bf16x8 __attribute__((ext_vector_type(8)));
typedef float f32x4 __attribute__((ext_vector_type(4)));
typedef unsigned u32x4 __attribute__((ext_vector_type(4)));
constexpr int BM = 256, BK = 64, HALF = 128, HTB = HALF * BK * 2, STAGE_BYTES = 8 * HTB, NXCD = 8, WGM = 8;

__host__ __device__ __forceinline__ int lds_byte(int r, int c) { const int st = (r >> 4) * 2 + (c >> 5), rr = r & 15, cc = c & 31, ob = rr * 64 + cc * 2; return st * 1024 + (ob ^ (((ob >> 9) & 1) << 5)); }
__host__ __device__ __forceinline__ void stage_rc(int b, int& R, int& C) { const int st = b / 1024, sb = b % 1024, swz = sb ^ (((sb >> 9) & 1) << 5); R = (st >> 1) * 16 + swz / 64; C = (st & 1) * 32 + (swz % 64) / 2; }
__host__ __device__ __forceinline__ int perm32(int rho) { const int n = rho >> 4, i = rho & 15; return 8 * (i >> 2) + 4 * n + (i & 3); }

struct Unit { int pm, pn, ks, nt; };
struct Gemm { const bf16_t* A; const bf16_t* Bt; int M, N, K, lda, ldb; };

struct StaticOrder {
    int nM, nN, nwg, G, c;
    __host__ __device__ void init(int M, int N, int G_, int c_) { nM = M / BM; nN = N / BM; nwg = nM * nN; G = G_; c = c_; }
    __host__ __device__ bool next(int i, Unit& u) const {
        if (c < 0) return false;
        const long L = (long)i * G + c; if (L >= nwg) return false;
        int wgid = (int)L; { const int q = nwg / NXCD, r = nwg % NXCD, xcd = wgid % NXCD, off = wgid / NXCD; wgid = (xcd < r ? xcd * (q + 1) : r * (q + 1) + (xcd - r) * q) + off; }
        const int nig = WGM * nN, gid = wgid / nig, fm = gid * WGM, gsz = (nM - fm) < WGM ? (nM - fm) : WGM;
        u.pm = fm + ((wgid % nig) % gsz); u.pn = (wgid % nig) / gsz; u.ks = 0; u.nt = 0; return true;
    }
    __device__ __forceinline__ void a_ready(const Unit&) const {}
    __device__ __forceinline__ void done(const Unit&) const {}
};

struct ColOrder {
    int nM, G, c;
    __device__ bool next(int i, Unit& u) const { const long L = (long)i * G + c; if (L >= 2L * nM) return false; u.pm = (int)(L % nM); u.pn = (L / nM) ? 16 : 0; u.ks = 0; u.nt = 0; return true; }
    __device__ __forceinline__ void a_ready(const Unit&) const {}
    __device__ __forceinline__ void done(const Unit&) const {}
};
struct UpOrder {
    int nM, G, c;
    __device__ bool next(int i, Unit& u) const { if (c < 0) return false; const long L = (long)i * G + c; if (L >= 7L * nM) return false;
        u.pn = (int)(L % 7); u.pm = (int)(L / 7); u.ks = u.pn < 3 ? 0 : 1; u.nt = u.pn < 3 ? 6 : 4; return true; }
    __device__ __forceinline__ void a_ready(const Unit&) const {}
    __device__ __forceinline__ void done(const Unit&) const {}
};
struct SplitOrder {
    int pm0, npm, nN, nks, G, c;
    __device__ bool next(int i, Unit& u) const { const long L = (long)i * G + c; if (L >= (long)npm * nN * nks) return false;
        const int l = (int)L; u.ks = l % nks; u.pn = (l / nks) % nN; u.pm = pm0 + l / (nks * nN); u.nt = 0; return true; }
    __device__ __forceinline__ void a_ready(const Unit&) const {}
    __device__ __forceinline__ void done(const Unit&) const {}
};
__device__ __forceinline__ unsigned cvt_pk_bf16(float lo, float hi) { unsigned r; asm volatile("v_cvt_pk_bf16_f32 %0, %1, %2" : "=v"(r) : "v"(lo), "v"(hi)); return r; }

struct EpiBf16 {
    static constexpr bool PERM = true, AFTER_DRAIN = false;
    bf16_t* O; int ldc;
    __device__ __forceinline__ void operator()(const f32x4 (&acc)[2][2][4][2], const Unit& u, int wr, int wc, int fr, int fq) const {
        const int row0 = u.pm * BM + wr * 64 + fr; const int col0 = u.pn * BM + wc * 32 + 8 * fq;
#pragma unroll
        for (int ai = 0; ai < 2; ++ai)
#pragma unroll
            for (int m = 0; m < 4; ++m) { bf16_t* rowp = O + (size_t)(row0 + ai * HALF + m * 16) * ldc + col0;
#pragma unroll
                for (int bj = 0; bj < 2; ++bj) { const f32x4 v0 = acc[ai][bj][m][0], v1 = acc[ai][bj][m][1];
                    u32x4 w; w.x = cvt_pk_bf16(v0[0], v0[1]); w.y = cvt_pk_bf16(v0[2], v0[3]); w.z = cvt_pk_bf16(v1[0], v1[1]); w.w = cvt_pk_bf16(v1[2], v1[3]);
                    *(u32x4*)(rowp + bj * HALF) = w; } }
    }
};

struct EpiUp {
    static constexpr bool PERM = true, AFTER_DRAIN = false;
    bf16_t* O; int ldc; const float2* T64; int nlat;
    __device__ __forceinline__ void operator()(const f32x4 (&acc)[2][2][4][2], const Unit& u, int wr, int wc, int fr, int fq) const {
        const int row0 = u.pm * BM + wr * 64 + fr; const int col0 = u.pn * BM + wc * 32 + 8 * fq;
#pragma unroll
        for (int bj = 0; bj < 2; ++bj) {
            const int cblk = u.pn * BM + bj * HALF + wc * 32;
            const bool isrope = (cblk < 768) && ((cblk % 192) >= 128) && (u.pm * BM < nlat);
            const int colsel = ((cblk % 192) - 128) >> 5;
#pragma unroll
            for (int ai = 0; ai < 2; ++ai)
#pragma unroll
                for (int m = 0; m < 4; ++m) { const int row = row0 + ai * HALF + m * 16;
                    f32x4 v0 = acc[ai][bj][m][0], v1 = acc[ai][bj][m][1];
                    if (isrope) { const int t = row & 4095; const int pos = colsel ? (t & 63) : (t >> 6); const float sgn = (fq & 2) ? 1.0f : -1.0f;
                        const float2* tb = T64 + pos * 16 + (8 * (fq & 1));
#pragma unroll
                        for (int j = 0; j < 4; ++j) { const float2 c0 = tb[j], c1 = tb[4 + j];
                            const float o0 = bperm_((fq * 16 + fr) ^ 32, v0[j]), o1 = bperm_((fq * 16 + fr) ^ 32, v1[j]);
                            v0[j] = v0[j] * c0.x + sgn * o0 * c0.y; v1[j] = v1[j] * c1.x + sgn * o1 * c1.y; } }
                    u32x4 w; w.x = cvt_pk_bf16(v0[0], v0[1]); w.y = cvt_pk_bf16(v0[2], v0[3]); w.z = cvt_pk_bf16(v1[0], v1[1]); w.w = cvt_pk_bf16(v1[2], v1[3]);
                    *(u32x4*)(O + (size_t)row * ldc + col0 + bj * HALF) = w; }
        }
    }
};
struct EpiSplit {
    static constexpr bool PERM = true, AFTER_DRAIN = false;
    bf16_t* O; int ldc;
    __device__ __forceinline__ void operator()(const f32x4 (&acc)[2][2][4][2], const Unit& u, int wr, int wc, int fr, int fq) const {
        const int row0 = (u.pm - 64) * BM + wr * 64 + fr; const int col0 = u.pn * BM + wc * 32 + 8 * fq; bf16_t* base = O + (size_t)u.ks * 1024 * ldc;
#pragma unroll
        for (int ai = 0; ai < 2; ++ai)
#pragma unroll
            for (int m = 0; m < 4; ++m) { bf16_t* rowp = base + (size_t)(row0 + ai * HALF + m * 16) * ldc + col0;
#pragma unroll
                for (int bj = 0; bj < 2; ++bj) { const f32x4 v0 = acc[ai][bj][m][0], v1 = acc[ai][bj][m][1];
                    u32x4 w; w.x = cvt_pk_bf16(v0[0], v0[1]); w.y = cvt_pk_bf16(v0[2], v0[3]); w.z = cvt_pk_bf16(v1[0], v1[1]); w.w = cvt_pk_bf16(v1[2], v1[3]);
                    *(u32x4*)(rowp + bj * HALF) = w; } }
    }
};
struct EpiF32 {
    static constexpr bool PERM = false, AFTER_DRAIN = false;
    float* O; int ldc;
    __device__ __forceinline__ void operator()(const f32x4 (&acc)[2][2][4][2], const Unit& u, int wr, int wc, int fr, int fq) const {
        const int row0 = u.pm * BM + wr * 64 + fr; const int col0 = u.pn * BM + wc * 32 + 4 * fq;
#pragma unroll
        for (int ai = 0; ai < 2; ++ai)
#pragma unroll
            for (int m = 0; m < 4; ++m) { float* rowp = O + (size_t)(row0 + ai * HALF + m * 16) * ldc + col0;
#pragma unroll
                for (int bj = 0; bj < 2; ++bj)
#pragma unroll
                    for (int n = 0; n < 2; ++n) *(f32x4*)(rowp + bj * HALF + n * 16) = acc[ai][bj][m][n]; }
    }
};
constexpr int FFC = 5632;
struct EpiConv {
    static constexpr bool PERM = true, AFTER_DRAIN = false;
    bf16_t* HD; const float* cw; const float* cb; float* Eg; float* Eu; PG8_LAS float* X; PG8_LAS float* CW;
    __device__ __forceinline__ void operator()(const f32x4 (&acc)[2][2][4][2], const Unit& u, int wr, int wc, int fr, int fq) const {
        const int cl = wc * 32 + 8 * fq; const int ch0 = u.pn * 128 + cl;
#pragma unroll
        for (int ai = 0; ai < 2; ++ai) { const int blk = 2 * ai + wr;
            if (fr == 0) {
#pragma unroll
                for (int n = 0; n < 2; ++n) *(PG8_LAS f32x4*)(X + (blk * 2 + 0) * 128 + cl + 4 * n) = acc[ai][0][0][n]; }
            if (fr == 15) {
#pragma unroll
                for (int n = 0; n < 2; ++n) *(PG8_LAS f32x4*)(X + (blk * 2 + 1) * 128 + cl + 4 * n) = acc[ai][0][3][n]; } }
        { const int t = (wr * 4 + wc) * 64 + fq * 16 + fr, k = t >> 7, c = t & 127;
          CW[t] = (k < 3) ? cw[k * FFC + u.pn * 128 + c] : cb[u.pn * 128 + c]; }
        asm volatile("s_waitcnt lgkmcnt(0)" ::: "memory"); __builtin_amdgcn_s_barrier(); asm volatile("" ::: "memory");
        const int lane = fq * 16 + fr; const int srcR = (lane & 48) | ((fr + 15) & 15), srcL = (lane & 48) | ((fr + 1) & 15);
#pragma unroll
        for (int ai = 0; ai < 2; ++ai) { const int blk = 2 * ai + wr; unsigned hb[4][2];
#pragma unroll
            for (int n = 0; n < 2; ++n) {
                const f32x4 w0 = *(const PG8_LAS f32x4*)(CW + cl + 4 * n), w1 = *(const PG8_LAS f32x4*)(CW + 128 + cl + 4 * n), w2 = *(const PG8_LAS f32x4*)(CW + 256 + cl + 4 * n), bb = *(const PG8_LAS f32x4*)(CW + 384 + cl + 4 * n);
                f32x4 ep = (f32x4){0.f, 0.f, 0.f, 0.f}, en = (f32x4){0.f, 0.f, 0.f, 0.f};
                if (blk > 0) ep = *(const PG8_LAS f32x4*)(X + ((blk - 1) * 2 + 1) * 128 + cl + 4 * n);
                if (blk < 3) en = *(const PG8_LAS f32x4*)(X + ((blk + 1) * 2 + 0) * 128 + cl + 4 * n);
                f32x4 R[4], L[4];
#pragma unroll
                for (int m = 0; m < 4; ++m)
#pragma unroll
                    for (int j = 0; j < 4; ++j) { R[m][j] = bperm_(srcR, acc[ai][0][m][n][j]); L[m][j] = bperm_(srcL, acc[ai][0][m][n][j]); }
#pragma unroll
                for (int m = 0; m < 4; ++m) {
                    const f32x4 prev = (fr == 0) ? (m > 0 ? R[m > 0 ? m - 1 : 0] : ep) : R[m];
                    const f32x4 next = (fr == 15) ? (m < 3 ? L[m < 3 ? m + 1 : 3] : en) : L[m];
                    const f32x4 a = w0 * prev + w1 * acc[ai][0][m][n] + w2 * next + bb;
                    f32x4 h;
#pragma unroll
                    for (int j = 0; j < 4; ++j) { const float e = __builtin_amdgcn_exp2f(-1.4426950408889634f * a[j]); h[j] = a[j] * __builtin_amdgcn_rcpf(1.0f + e) * acc[ai][1][m][n][j]; }
                    if (n == 0) { hb[m][0] = cvt_pk_bf16(h[0], h[1]); hb[m][1] = cvt_pk_bf16(h[2], h[3]); }
                    else { u32x4 w; w.x = hb[m][0]; w.y = hb[m][1]; w.z = cvt_pk_bf16(h[0], h[1]); w.w = cvt_pk_bf16(h[2], h[3]);
                        *(u32x4*)(HD + (size_t)(u.pm * BM + ai * HALF + wr * 64 + m * 16 + fr) * FFC + ch0) = w; }
                }
            }
        }
        if (wr == 0 && fr < 2) {
#pragma unroll
            for (int n = 0; n < 2; ++n) { *(f32x4*)(Eg + (size_t)(u.pm * 4 + fr) * FFC + ch0 + 4 * n) = acc[0][0][0][n];
                if (fr == 0) *(f32x4*)(Eu + (size_t)(u.pm * 2 + 0) * FFC + ch0 + 4 * n) = acc[0][1][0][n]; } }
        if (wr == 1 && fr >= 14) {
#pragma unroll
            for (int n = 0; n < 2; ++n) { *(f32x4*)(Eg + (size_t)(u.pm * 4 + 2 + (fr - 14)) * FFC + ch0 + 4 * n) = acc[1][0][3][n];
                if (fr == 15) *(f32x4*)(Eu + (size_t)(u.pm * 2 + 1) * FFC + ch0 + 4 * n) = acc[1][1][3][n]; } }
    }
};

template <class Epi, class Sched, bool ALIGN_EPI = false, bool SP2 = false>
__device__ __forceinline__ void gemm_phase(PG8_LAS unsigned char* lds, const Gemm g, const Sched& S, const Epi& E, int wv) {
    int tid = wv * 64 + lane_id_(); asm volatile("" : "+v"(tid));
    const int wid = __builtin_amdgcn_readfirstlane(tid >> 6), lane = tid & 63, wr = wid >> 2, wc = wid & 3, fr = lane & 15, fq = lane >> 4;
    const int K = g.K, nt = K / BK;
    unsigned voffA[2], voffB[2];
#pragma unroll
    for (int i = 0; i < 2; ++i) { int R, C; stage_rc(tid * 16 + i * 8192, R, C); const int Rb = Epi::PERM ? ((R & ~31) + perm32(R & 31)) : R;
        voffA[i] = (unsigned)(R * g.lda + C) * 2u; voffB[i] = (unsigned)(Rb * g.ldb + C) * 2u; }
    const size_t kstep = (size_t)(BK * 2);
    const size_t hsA = (size_t)HALF * g.lda * 2, hsB = (size_t)HALF * g.ldb * 2;
    const size_t tsA = 2 * hsA, tsB = 2 * hsB, kofs = (size_t)K * 2;
    const unsigned ldsw = (unsigned)wid * 1024u;
    const int aoff = lds_byte(wr * 64 + fr, fq * 8), boff = lds_byte(wc * 32 + fr, fq * 8);
#define PG8_SA(b, h) (((b) * 2 + (h)) * HTB)
#define PG8_SB(b, h) ((4 + (b) * 2 + (h)) * HTB)
#define PG8_STAGE(bufoff, gbase, voff) do { _Pragma("unroll") for (int _i = 0; _i < 2; ++_i) \
        __builtin_amdgcn_global_load_lds((const unsigned*)((const char*)(gbase) + (voff)[_i]), (PG8_LAS unsigned*)(lds + (bufoff) + ldsw + _i * 8192), 16, 0, 0); } while (0)
#define PG8_LDA(dst, b, h) do { _Pragma("unroll") for (int m = 0; m < 4; ++m) _Pragma("unroll") for (int k = 0; k < 2; ++k) dst[m][k] = *(const PG8_LAS bf16x8*)(lds + PG8_SA(b, h) + aoff + m * 2048 + k * 1024); } while (0)
#define PG8_LDB(dst, b, h) do { _Pragma("unroll") for (int n = 0; n < 2; ++n) _Pragma("unroll") for (int k = 0; k < 2; ++k) dst[n][k] = *(const PG8_LAS bf16x8*)(lds + PG8_SB(b, h) + boff + n * 2048 + k * 1024); } while (0)
#define PG8_MMA(ai, bj, At, Bt) do { __builtin_amdgcn_s_setprio(1); _Pragma("unroll") for (int m = 0; m < 4; ++m) _Pragma("unroll") for (int n = 0; n < 2; ++n) _Pragma("unroll") for (int k = 0; k < 2; ++k) \
        acc[ai][bj][m][n] = __builtin_amdgcn_mfma_f32_16x16x32_bf16(Bt[n][k], At[m][k], acc[ai][bj][m][n], 0, 0, 0); __builtin_amdgcn_s_setprio(0); } while (0)
#define PG8_WAIT_V(n) asm volatile("s_waitcnt vmcnt(" #n ")" ::: "memory")
#define PG8_WAIT_L(n) asm volatile("s_waitcnt lgkmcnt(" #n ")" ::: "memory")
#define PG8_BAR __builtin_amdgcn_s_barrier()
#define PG8_SCHED __builtin_amdgcn_sched_barrier(0)
    Unit cur, nxt; int ui = 0;
    if (!S.next(0, cur)) return;
    f32x4 acc[2][2][4][2];
#pragma unroll
    for (int a = 0; a < 2; ++a)
#pragma unroll
        for (int b = 0; b < 2; ++b)
#pragma unroll
            for (int m = 0; m < 4; ++m)
#pragma unroll
                for (int n = 0; n < 2; ++n) acc[a][b][m][n] = (f32x4){0.f, 0.f, 0.f, 0.f};
    bf16x8 At[4][2], B0[2][2], B1[2][2];
    const char* cA = (const char*)g.A + (size_t)cur.pm * tsA + (size_t)cur.ks * kofs; const char* cB = (const char*)g.Bt + (size_t)cur.pn * tsB + (size_t)cur.ks * kofs;
    S.a_ready(cur);
    if constexpr (SP2) {
        PG8_STAGE(PG8_SB(0, 0), cB, voffB); PG8_STAGE(PG8_SB(0, 1), cB + hsB, voffB); PG8_STAGE(PG8_SA(0, 0), cA, voffA); PG8_STAGE(PG8_SA(0, 1), cA + hsA, voffA);
        if (wr == 1) PG8_BAR;
        PG8_WAIT_V(2); PG8_BAR;
        PG8_STAGE(PG8_SB(1, 0), cB + kstep, voffB); PG8_STAGE(PG8_SA(1, 0), cA + kstep, voffA); PG8_STAGE(PG8_SB(1, 1), cB + hsB + kstep, voffB);
        PG8_WAIT_V(6); PG8_BAR;
    } else {
        PG8_STAGE(PG8_SB(0, 0), cB, voffB); PG8_STAGE(PG8_SA(0, 0), cA, voffA); PG8_STAGE(PG8_SB(0, 1), cB + hsB, voffB); PG8_STAGE(PG8_SA(0, 1), cA + hsA, voffA);
        if (wr == 1) PG8_BAR;
        PG8_WAIT_V(4); PG8_BAR;
        PG8_STAGE(PG8_SB(1, 0), cB + kstep, voffB); PG8_STAGE(PG8_SA(1, 0), cA + kstep, voffA); PG8_STAGE(PG8_SB(1, 1), cB + hsB + kstep, voffB);
        PG8_WAIT_V(6); PG8_BAR;
    }
    for (;;) {
        const bool has_next = S.next(ui + 1, nxt);
        const char* nA = has_next ? (const char*)g.A + (size_t)nxt.pm * tsA + (size_t)nxt.ks * kofs : cA; const char* nB = has_next ? (const char*)g.Bt + (size_t)nxt.pn * tsB + (size_t)nxt.ks * kofs : cB;
        const int ntu = cur.nt ? cur.nt : nt;
        for (int t = 0; t < ntu; t += 2) {
            const bool last = (t == ntu - 2);
            const char* a1 = cA + (size_t)(t + 1) * kstep;
            const char* a2 = last ? nA : cA + (size_t)(t + 2) * kstep; const char* b2 = last ? nB : cB + (size_t)(t + 2) * kstep;
            const char* a3 = a2 + kstep; const char* b3 = b2 + kstep;
            if (last && has_next) S.a_ready(nxt);
            if constexpr (SP2) {
            PG8_LDB(B0, 0, 0); PG8_LDB(B1, 0, 1); PG8_SCHED; PG8_LDA(At, 0, 0); PG8_STAGE(PG8_SA(1, 1), a1 + hsA, voffA);
            PG8_WAIT_V(8); PG8_WAIT_L(0); PG8_BAR; PG8_MMA(0, 0, At, B0); PG8_MMA(0, 1, At, B1); PG8_BAR; PG8_SCHED;
            PG8_LDA(At, 0, 1); PG8_STAGE(PG8_SB(0, 0), b2, voffB); PG8_STAGE(PG8_SB(0, 1), b2 + hsB, voffB); PG8_STAGE(PG8_SA(0, 0), a2, voffA);
            PG8_WAIT_V(8); PG8_WAIT_L(0); PG8_BAR; PG8_MMA(1, 0, At, B0); PG8_MMA(1, 1, At, B1); PG8_BAR; PG8_SCHED;
            PG8_LDB(B0, 1, 0); PG8_LDB(B1, 1, 1); PG8_SCHED; PG8_LDA(At, 1, 0); PG8_STAGE(PG8_SA(0, 1), a2 + hsA, voffA);
            PG8_WAIT_V(8); PG8_WAIT_L(0); PG8_BAR; PG8_MMA(0, 0, At, B0); PG8_MMA(0, 1, At, B1); PG8_BAR; PG8_SCHED;
            PG8_LDA(At, 1, 1); PG8_STAGE(PG8_SB(1, 0), b3, voffB); PG8_STAGE(PG8_SB(1, 1), b3 + hsB, voffB); PG8_STAGE(PG8_SA(1, 0), a3, voffA);
            PG8_WAIT_V(8); PG8_WAIT_L(0); PG8_BAR; PG8_MMA(1, 0, At, B0); PG8_MMA(1, 1, At, B1); PG8_BAR; PG8_SCHED;
            } else {
            PG8_LDB(B0, 0, 0); PG8_SCHED; PG8_LDA(At, 0, 0); PG8_STAGE(PG8_SA(1, 1), a1 + hsA, voffA);
            PG8_WAIT_L(8); PG8_BAR; PG8_WAIT_L(0); PG8_MMA(0, 0, At, B0); PG8_BAR; PG8_SCHED;
            PG8_LDB(B1, 0, 1); PG8_STAGE(PG8_SB(0, 0), b2, voffB);
            PG8_BAR; PG8_WAIT_L(0); PG8_MMA(0, 1, At, B1); PG8_BAR;
            PG8_LDA(At, 0, 1); PG8_STAGE(PG8_SA(0, 0), a2, voffA);
            PG8_BAR; PG8_WAIT_L(0); PG8_MMA(1, 0, At, B0); PG8_BAR; PG8_SCHED;
            PG8_STAGE(PG8_SB(0, 1), b2 + hsB, voffB);
            PG8_WAIT_V(6); PG8_BAR; PG8_MMA(1, 1, At, B1); PG8_BAR;
            PG8_LDB(B0, 1, 0); PG8_SCHED; PG8_LDA(At, 1, 0); PG8_STAGE(PG8_SA(0, 1), a2 + hsA, voffA);
            PG8_WAIT_L(8); PG8_BAR; PG8_WAIT_L(0); PG8_MMA(0, 0, At, B0); PG8_BAR; PG8_SCHED;
            PG8_LDB(B1, 1, 1); PG8_STAGE(PG8_SB(1, 0), b3, voffB);
            PG8_BAR; PG8_WAIT_L(0); PG8_MMA(0, 1, At, B1); PG8_BAR;
            PG8_LDA(At, 1, 1); PG8_STAGE(PG8_SA(1, 0), a3, voffA);
            PG8_BAR; PG8_WAIT_L(0); PG8_MMA(1, 0, At, B0); PG8_BAR; PG8_SCHED;
            PG8_STAGE(PG8_SB(1, 1), b3 + hsB, voffB);
            PG8_WAIT_V(6); PG8_BAR; PG8_MMA(1, 1, At, B1); PG8_BAR;
            }
        }
        if constexpr (ALIGN_EPI) { if (wr == 0) PG8_BAR; }
        if constexpr (!Epi::AFTER_DRAIN) { E(acc, cur, wr, wc, fr, fq); S.done(cur); }
        if (!has_next) break;
#pragma unroll
        for (int a = 0; a < 2; ++a)
#pragma unroll
            for (int b = 0; b < 2; ++b)
#pragma unroll
                for (int m = 0; m < 4; ++m)
#pragma unroll
                    for (int n = 0; n < 2; ++n) acc[a][b][m][n] = (f32x4){0.f, 0.f, 0.f, 0.f};
        cur = nxt; cA = nA; cB = nB; ++ui;
        if constexpr (ALIGN_EPI) { if (wr == 1) PG8_BAR; }
    }
    PG8_WAIT_V(0);
    if constexpr (!ALIGN_EPI) { if (wr == 0) PG8_BAR; }
    PG8_BAR;
#undef PG8_SA
#undef PG8_SB
#undef PG8_STAGE
#undef PG8_LDA
#undef PG8_LDB
#undef PG8_MMA
#undef PG8_WAIT_V
#undef PG8_WAIT_L
#undef PG8_BAR
#undef PG8_SCHED
}
}

namespace att {
typedef unsigned short bf16_t;
using bf16x8 = __attribute__((ext_vector_type(8))) short;
using s16x4  = __attribute__((ext_vector_type(4))) short;
using f32x16 = __attribute__((ext_vector_type(16))) float;
using u32x4  = __attribute__((ext_vector_type(4))) unsigned;
constexpr int NW = 8, QBLK = 32, KVBLK = 64;
constexpr float THR = 8.f;
constexpr int SHM_V = 16384, SHM_K = 16384, SHM_KR = 8192;
constexpr int OFF_V = 0, OFF_K = 2 * SHM_V, OFF_WS = OFF_K + 2 * SHM_K, OFF_KR = OFF_WS + 2048, OFF_RPB = OFF_KR + 2 * SHM_KR, OFF_Q2 = OFF_RPB + 2048, LDS_TOTAL = OFF_Q2 + 32768;
#define KSWZ(row, colB) ((row) * 256 + ((colB) ^ (((row) & 7) << 4)))
#define KRSWZ(row, colB) ((row) * 128 + ((colB) ^ ((((row) >> 1) & 7) << 4)))
#define SBAR() __builtin_amdgcn_sched_barrier(0)
__device__ __forceinline__ int crow(int r, int hi) { return (r & 3) + 8 * (r >> 2) + 4 * hi; }
__device__ __forceinline__ unsigned cvtpk(float lo, float hi) { unsigned r; asm volatile("v_cvt_pk_bf16_f32 %0, %1, %2" : "=v"(r) : "v"(lo), "v"(hi)); return r; }
__device__ __forceinline__ unsigned short f2bf(float f) { unsigned u = __builtin_bit_cast(unsigned, f); return (unsigned short)((u + 0x7fffu + ((u >> 16) & 1u)) >> 16); }

template <bool MLA> __device__ __forceinline__ void partialSM(f32x16& p0, f32x16& p1, float& m_reg, float& mn, float& alpha) {
  constexpr float SCALE = MLA ? 0.07216878364870322f : 0.08838834764831845f;
  constexpr float C = SCALE * 1.4426950408889634f;
  float pmax = p0[0];
#pragma unroll
  for (int r = 1; r < 16; ++r) pmax = fmaxf(pmax, p0[r]);
#pragma unroll
  for (int r = 0; r < 16; ++r) pmax = fmaxf(pmax, p1[r]);
  { auto rr = __builtin_amdgcn_permlane32_swap(__float_as_uint(pmax), __float_as_uint(pmax), false, false);
    pmax = fmaxf(__uint_as_float(rr[0]), __uint_as_float(rr[1])); }
  if (__builtin_expect(__all(pmax - m_reg <= THR / SCALE), 1)) { mn = m_reg; alpha = 1.f; }
  else { mn = fmaxf(m_reg, pmax); alpha = __builtin_amdgcn_exp2f((m_reg - mn) * C); m_reg = mn; }
  float mnC = -mn * C;
#pragma unroll
  for (int r = 0; r < 16; ++r) p0[r] = fmaf(p0[r], C, mnC);
#pragma unroll
  for (int r = 0; r < 16; ++r) p1[r] = fmaf(p1[r], C, mnC);
#pragma unroll
  for (int r = 0; r < 16; ++r) p0[r] = __builtin_amdgcn_exp2f(p0[r]);
}
__device__ __forceinline__ void finishSM(f32x16& p0, f32x16& p1, float alpha, float& l_reg, bf16x8& pa0, bf16x8& pa1, bf16x8& pa2, bf16x8& pa3) {
#pragma unroll
  for (int r = 0; r < 16; ++r) p1[r] = __builtin_amdgcn_exp2f(p1[r]);
  float ps = 0;
#pragma unroll
  for (int r = 0; r < 16; ++r) ps += p0[r];
#pragma unroll
  for (int r = 0; r < 16; ++r) ps += p1[r];
  { auto rr = __builtin_amdgcn_permlane32_swap(__float_as_uint(ps), __float_as_uint(ps), false, false);
    ps = __uint_as_float(rr[0]) + __uint_as_float(rr[1]); }
  l_reg = l_reg * alpha + ps;
#define PK4(P, BASE, OUT) do { unsigned a0 = cvtpk(P[BASE + 0], P[BASE + 1]), a1 = cvtpk(P[BASE + 2], P[BASE + 3]);   \
    unsigned b0 = cvtpk(P[BASE + 4], P[BASE + 5]), b1 = cvtpk(P[BASE + 6], P[BASE + 7]);                              \
    auto r0 = __builtin_amdgcn_permlane32_swap(a0, b0, false, false); auto r1 = __builtin_amdgcn_permlane32_swap(a1, b1, false, false); \
    u32x4 w = {r0[0], r1[0], r0[1], r1[1]}; OUT = *reinterpret_cast<bf16x8*>(&w); } while (0)
  PK4(p0, 0, pa0); PK4(p0, 8, pa1); PK4(p1, 0, pa2); PK4(p1, 8, pa3);
#undef PK4
}
template <bool MLA> __device__ __forceinline__ void qkt(f32x16& p0, f32x16& p1, const bf16_t* Ks, const bf16_t* KRs, const bf16x8* qr, const char* q2l, int r32, int hi) {
  p0 = f32x16{}; p1 = f32x16{};
#pragma unroll
  for (int d0 = 0; d0 < 8; ++d0) { int cb = (d0 * 16 + hi * 8) * 2;
    bf16x8 b0 = *reinterpret_cast<const bf16x8*>((const char*)Ks + KSWZ(r32, cb));
    bf16x8 b1 = *reinterpret_cast<const bf16x8*>((const char*)Ks + KSWZ(32 + r32, cb));
    p0 = __builtin_amdgcn_mfma_f32_32x32x16_bf16(b0, qr[d0], p0, 0, 0, 0);
    p1 = __builtin_amdgcn_mfma_f32_32x32x16_bf16(b1, qr[d0], p1, 0, 0, 0); }
  if constexpr (MLA) {
#pragma unroll
    for (int d0 = 0; d0 < 4; ++d0) { int cb = (d0 * 16 + hi * 8) * 2;
      bf16x8 b0 = *reinterpret_cast<const bf16x8*>((const char*)KRs + KRSWZ(r32, cb));
      bf16x8 b1 = *reinterpret_cast<const bf16x8*>((const char*)KRs + KRSWZ(32 + r32, cb));
      const bf16x8 q2 = *reinterpret_cast<const bf16x8*>(q2l + d0 * 1024);
      p0 = __builtin_amdgcn_mfma_f32_32x32x16_bf16(b0, q2, p0, 0, 0, 0);
      p1 = __builtin_amdgcn_mfma_f32_32x32x16_bf16(b1, q2, p1, 0, 0, 0); }
  }
}
__device__ __forceinline__ int v_st(int k, int c) { const int kk = (k & ~0xC) | ((k & 4) << 1) | ((k & 8) >> 1); return ((kk >> 3) * 4 + (c >> 5)) * 512 + ((kk & 7) * 32 + (c & 31)) * 2; }
__device__ __forceinline__ int v_rd_base(int lane) { return ((lane & 3) << 3) | (((lane >> 2) & 3) << 6) | (((lane >> 4) & 1) << 5) | (((lane >> 5) & 1) << 8); }
constexpr int v_rd_off(int d0, int ks, int half) { return d0 * 512 + ks * 4096 + half * 2048; }
template <int OFF> __device__ __forceinline__ s16x4 tr_read(int vb) {
  s16x4 r; asm volatile("ds_read_b64_tr_b16 %0, %1 offset:%2" : "=&v"(r) : "v"(vb), "i"(OFF) : "memory"); return r;
}
template <int D0> __device__ __forceinline__ void pv_one(f32x16& od, int vb, bf16x8 pa0, bf16x8 pa1, bf16x8 pa2, bf16x8 pa3) {
  const s16x4 l0 = tr_read<v_rd_off(D0, 0, 0)>(vb), h0 = tr_read<v_rd_off(D0, 0, 1)>(vb), l1 = tr_read<v_rd_off(D0, 1, 0)>(vb), h1 = tr_read<v_rd_off(D0, 1, 1)>(vb);
  const s16x4 l2 = tr_read<v_rd_off(D0, 2, 0)>(vb), h2 = tr_read<v_rd_off(D0, 2, 1)>(vb), l3 = tr_read<v_rd_off(D0, 3, 0)>(vb), h3 = tr_read<v_rd_off(D0, 3, 1)>(vb);
  asm volatile("s_waitcnt lgkmcnt(0)" ::: "memory"); SBAR();
#define PK(L, H) (bf16x8){L[0], L[1], L[2], L[3], H[0], H[1], H[2], H[3]}
  od = __builtin_amdgcn_mfma_f32_32x32x16_bf16(pa0, PK(l0, h0), od, 0, 0, 0);
  od = __builtin_amdgcn_mfma_f32_32x32x16_bf16(pa1, PK(l1, h1), od, 0, 0, 0);
  od = __builtin_amdgcn_mfma_f32_32x32x16_bf16(pa2, PK(l2, h2), od, 0, 0, 0);
  od = __builtin_amdgcn_mfma_f32_32x32x16_bf16(pa3, PK(l3, h3), od, 0, 0, 0);
#undef PK
}
__device__ __forceinline__ void pv_d0(f32x16* o, int vb, bf16x8 pa0, bf16x8 pa1, bf16x8 pa2, bf16x8 pa3) {
  pv_one<0>(o[0], vb, pa0, pa1, pa2, pa3); pv_one<1>(o[1], vb, pa0, pa1, pa2, pa3); pv_one<2>(o[2], vb, pa0, pa1, pa2, pa3); pv_one<3>(o[3], vb, pa0, pa1, pa2, pa3);
}

struct AttnArgs {
  const bf16_t *Q, *Q2, *K, *V, *KR; bf16_t* O;
  int ldq, ldk, ldv, ldkr, ldo;
  int qrow0;
  int ctxrow0;
  int latrow0;
  int NT;
  int qpos0;
  int wstart;
  const float* sinkp; int has_sink;
  const float* rpb;
};

template <int MODE> __device__ __forceinline__ void apply_mask(f32x16& p0, f32x16& p1, int j, const AttnArgs& a, int qp, int hi, const float* rpbL) {
  constexpr float NEG = -1e30f;
  if constexpr (MODE == 2) {
    if (j >= 4) {
      const int kb = a.wstart + 64 * (j - 4) - qp;
#pragma unroll
      for (int r = 0; r < 16; ++r) { const int d0 = kb + crow(r, hi), d1 = d0 + 32;
        if (d0 < -128 || d0 > 128) p0[r] = NEG; if (d1 < -128 || d1 > 128) p1[r] = NEG; }
    }
  } else if constexpr (MODE == 1) {
    if (j >= 4) {
      int qp_ = qp; asm volatile("" : "+v"(qp_));
      const int krow = (a.wstart >> 6) + (j - 4); const int qrow = qp_ >> 6, qcol = qp_ & 63;
      const int r0 = min(max(qrow - 4, 0), 56), c0 = min(max(qcol - 8, 0), 48);
      const bool rowok = (krow >= r0) && (krow < r0 + 8);
      const float* bp = rpbL + min(max(krow - qrow + 7, 0), 14) * 31 + 15 - qcol + 4 * hi;
      const int lo = c0 - 4 * hi, hi_ = lo + 16;
#pragma unroll
      for (int r = 0; r < 16; ++r) { const int k0 = (r & 3) + 8 * (r >> 2), k1 = k0 + 32;
        const bool ok0 = rowok && (k0 >= lo) && (k0 < hi_), ok1 = rowok && (k1 >= lo) && (k1 < hi_);
        const float b0 = bp[k0], b1 = bp[k1];
        p0[r] = ok0 ? p0[r] + b0 : NEG; p1[r] = ok1 ? p1[r] + b1 : NEG; }
    }
  }
}

template <int MODE, bool MLA>
__device__ __forceinline__ void attn_unit(const AttnArgs& a, char* lds, int wv) {
  constexpr float SCALE = MLA ? 0.07216878364870322f : 0.08838834764831845f;
  constexpr float C = SCALE * 1.4426950408889634f;
  constexpr int SDEPTH = (MLA || MODE != 0) ? 1 : 2;
  int tid = wv * 64 + lane_id_(); asm volatile("" : "+v"(tid));
  const int wid = tid >> 6, lane = tid & 63, r32 = lane & 31, hi = lane >> 5;
  bf16_t* V_lds = (bf16_t*)(lds + OFF_V); bf16_t* K_lds = (bf16_t*)(lds + OFF_K); bf16_t* KR_lds = (bf16_t*)(lds + OFF_KR);
  float* ws = (float*)(lds + OFF_WS) + wid * 64; float* li_l = ws; float* al_l = ws + 32;
  float* rpbL = (float*)(lds + OFF_RPB);
  if constexpr (MODE == 1) { for (int i = tid; i < 465; i += 512) rpbL[i] = a.rpb[i] * (1.0f / SCALE); }
  float m_reg = -1e30f, l_reg = 0; f32x16 o[4] = {}; bf16x8 qr[8];
  const char* q2l = lds + OFF_Q2 + (wid * 4 * 64 + lane) * 16;
  const bf16_t* Qw = a.Q + (long)(a.qrow0 + wid * QBLK + r32) * a.ldq + hi * 8;
#pragma unroll
  for (int d0 = 0; d0 < 8; ++d0) qr[d0] = *reinterpret_cast<const bf16x8*>(Qw + d0 * 16);
  if constexpr (MLA) { const bf16_t* Q2w = a.Q2 + (long)(a.qrow0 + wid * QBLK + r32) * a.ldq + hi * 8;
#pragma unroll
    for (int d0 = 0; d0 < 4; ++d0) *(bf16x8*)(const_cast<char*>(q2l) + d0 * 1024) = *reinterpret_cast<const bf16x8*>(Q2w + d0 * 16); }
  const int qp = a.qpos0 + wid * QBLK + r32;
  const int sr = tid >> 4, sc = (tid & 15) * 8, vst0 = v_st(sr, sc), vst1 = v_st(32 + sr, sc);
  const int krr = tid >> 3, krc = (tid & 7) * 8;
  const int vb0 = (int)(uintptr_t)V_lds + v_rd_base(lane);
  struct { bf16x8 vs0, vs1, ks0, ks1, kr; } sr_[SDEPTH];
#define TROW(j) ((j) < 4 ? a.ctxrow0 + 64 * (j) : a.latrow0 + 64 * ((j) - 4))
#define SLOAD(i, j) do { const long row0_ = TROW(j); \
    sr_[i].vs0 = *reinterpret_cast<const bf16x8*>(&a.V[(row0_ + sr) * a.ldv + sc]); sr_[i].vs1 = *reinterpret_cast<const bf16x8*>(&a.V[(row0_ + 32 + sr) * a.ldv + sc]); \
    sr_[i].ks0 = *reinterpret_cast<const bf16x8*>(&a.K[(row0_ + sr) * a.ldk + sc]); sr_[i].ks1 = *reinterpret_cast<const bf16x8*>(&a.K[(row0_ + 32 + sr) * a.ldk + sc]); \
    if constexpr (MLA) sr_[i].kr = *reinterpret_cast<const bf16x8*>(&a.KR[(row0_ + krr) * a.ldkr + krc]); } while (0)
#define SWRITE(b, i) do { *(bf16x8*)((char*)V_lds + (b) * SHM_V + vst0) = sr_[i].vs0; \
    *(bf16x8*)((char*)V_lds + (b) * SHM_V + vst1) = sr_[i].vs1; int kc = sc * 2; \
    *(bf16x8*)((char*)K_lds + (b) * SHM_K + KSWZ(sr, kc)) = sr_[i].ks0; \
    *(bf16x8*)((char*)K_lds + (b) * SHM_K + KSWZ(32 + sr, kc)) = sr_[i].ks1; \
    if constexpr (MLA) *(bf16x8*)((char*)KR_lds + (b) * SHM_KR + KRSWZ(krr, krc * 2)) = sr_[i].kr; } while (0)
#define SWAIT() do { if constexpr (SDEPTH == 1) asm volatile("s_waitcnt vmcnt(0)" ::: "memory"); else asm volatile("s_waitcnt vmcnt(4)" ::: "memory"); } while (0)
#define RESC(al) do { if (__any((al) < 1.f)) { if (hi == 0) al_l[r32] = (al); asm volatile("s_waitcnt lgkmcnt(0)" ::: "memory"); \
    _Pragma("unroll") for (int d = 0; d < 4; ++d) _Pragma("unroll") for (int r = 0; r < 16; ++r) o[d][r] *= al_l[crow(r, hi)]; } } while (0)
#define KB(b) ((const bf16_t*)((const char*)K_lds + (b) * SHM_K))
#define KRB(b) ((const bf16_t*)((const char*)KR_lds + (b) * SHM_KR))
  f32x16 pA0, pA1, pB0, pB1; float mnA, mnB, alA, alB; bf16x8 pa0, pa1, pa2, pa3; const int NT = a.NT;
  constexpr int SE = 0, SO = SDEPTH - 1;
  const int qw0 = a.qpos0 + __builtin_amdgcn_readfirstlane(wid) * QBLK;
  auto skip = [&](int j) -> bool {
    if constexpr (MODE == 2) { if (j < 4) return false; const int kt = a.wstart + 64 * (j - 4); return (kt > qw0 + 31 + 128) || (kt + 63 < qw0 - 128); }
    else if constexpr (MODE == 1) { if (j < 4) return false; const int krow = (a.wstart >> 6) + (j - 4); const int r0 = min(max((qw0 >> 6) - 4, 0), 56); return !((krow >= r0) && (krow < r0 + 8)); }
    else return false; };
  SLOAD(SE, 0); asm volatile("s_waitcnt vmcnt(0)" ::: "memory"); SWRITE(0, SE); __syncthreads();
  qkt<MLA>(pA0, pA1, KB(0), KRB(0), qr, q2l, r32, hi); partialSM<MLA>(pA0, pA1, m_reg, mnA, alA);
  SLOAD(SO, 1); if constexpr (SDEPTH == 2) { if (2 < NT) SLOAD(SE, 2); }
  SWAIT(); SWRITE(1, SO); __syncthreads();
  bool skA = false;
  for (int j = 1; j + 1 < NT; j += 2) {
    const bool skB = skip(j), skA2 = skip(j + 1);
    SBAR(); if (!skB) qkt<MLA>(pB0, pB1, KB(1), KRB(1), qr, q2l, r32, hi);
    if (!skA) finishSM(pA0, pA1, alA, l_reg, pa0, pa1, pa2, pa3); SBAR();
    SLOAD(SO, j + SDEPTH); SBAR();
    if (!skA) pv_d0(o, vb0, pa0, pa1, pa2, pa3); SBAR();
    if (!skB) { apply_mask<MODE>(pB0, pB1, j, a, qp, hi, rpbL); partialSM<MLA>(pB0, pB1, m_reg, mnB, alB); } else alB = 1.f;
    __syncthreads(); SWAIT(); SWRITE(0, SE);
    RESC(alB); __syncthreads();
    SBAR(); if (!skA2) qkt<MLA>(pA0, pA1, KB(0), KRB(0), qr, q2l, r32, hi);
    if (!skB) finishSM(pB0, pB1, alB, l_reg, pa0, pa1, pa2, pa3); SBAR();
    if (SDEPTH == 1 || j + 3 < NT) SLOAD(SE, j + 1 + SDEPTH); SBAR();
    if (!skB) pv_d0(o, vb0 + (int)SHM_V, pa0, pa1, pa2, pa3); SBAR();
    if (!skA2) { apply_mask<MODE>(pA0, pA1, j + 1, a, qp, hi, rpbL); partialSM<MLA>(pA0, pA1, m_reg, mnA, alA); } else alA = 1.f;
    __syncthreads(); SWAIT(); SWRITE(1, SO);
    RESC(alA); __syncthreads();
    skA = skA2;
  }
  { const bool skB = skip(NT - 1);
    SBAR(); if (!skB) qkt<MLA>(pB0, pB1, KB(1), KRB(1), qr, q2l, r32, hi);
    if (!skA) finishSM(pA0, pA1, alA, l_reg, pa0, pa1, pa2, pa3); SBAR();
    if (!skA) pv_d0(o, vb0, pa0, pa1, pa2, pa3); SBAR();
    if (!skB) { apply_mask<MODE>(pB0, pB1, NT - 1, a, qp, hi, rpbL); partialSM<MLA>(pB0, pB1, m_reg, mnB, alB); } else alB = 1.f;
    __syncthreads(); RESC(alB);
    if (!skB) { finishSM(pB0, pB1, alB, l_reg, pa0, pa1, pa2, pa3); SBAR();
      pv_d0(o, vb0 + (int)SHM_V, pa0, pa1, pa2, pa3); } }
  if (a.has_sink) l_reg += __builtin_amdgcn_exp2f((a.sinkp[0] * (1.0f / SCALE) - m_reg) * C);
  if (hi == 0) li_l[r32] = l_reg;
  __syncthreads();
  { char* stg = lds + wid * 8192;
#pragma unroll
    for (int r = 0; r < 16; ++r) { const int orow = crow(r, hi); const float rl = __builtin_amdgcn_rcpf(li_l[orow]);
#pragma unroll
      for (int d0 = 0; d0 < 4; ++d0) *(bf16_t*)(stg + orow * 256 + (d0 * 32 + r32) * 2) = f2bf(o[d0][r] * rl); }
    asm volatile("s_waitcnt lgkmcnt(0)" ::: "memory");
    bf16_t* Ow = a.O + (long)(a.qrow0 + wid * QBLK) * a.ldo;
#pragma unroll
    for (int i = 0; i < 8; ++i) { const int row = i * 4 + (lane >> 4), ch = lane & 15;
      const u32x4 v = *(const u32x4*)(stg + row * 256 + ch * 16);
      *(u32x4*)(Ow + (long)row * a.ldo + ch * 8) = v; } }
  __syncthreads();
#undef TROW
#undef SLOAD
#undef SWRITE
#undef SWAIT
#undef RESC
#undef KB
#undef KRB
}
#undef SBAR
}

typedef unsigned short bf16;
typedef float f32x4 __attribute__((ext_vector_type(4)));
typedef unsigned v4u __attribute__((ext_vector_type(4)));
typedef unsigned v2u __attribute__((ext_vector_type(2)));
#define LAS __attribute__((address_space(3)))
constexpr int DM = 2048, NB = 4, SEQ = 4096, CTX = 256, NLAT = NB * SEQ, NCTX = NB * CTX, MTOT = NLAT + NCTX;
constexpr int INC = 4160, INP = 4352, FF = 5632, UPN = 1792, UPK = 512;
constexpr float ALPHA = 1.4142135623730951f, EPS = 1e-6f;
constexpr size_t MiB = 1u << 20;
constexpr size_t WS_MOD = 1 * MiB, WS_ROPE = 2 * MiB, WS_EDGE = 3 * MiB, WS_WUP = 14 * MiB, WS_WIN = 18 * MiB, WS_WOUT = 52 * MiB, WS_WGU = 68 * MiB, WS_WDN = 156 * MiB,
                 WS_X = 200 * MiB, WS_H = 336 * MiB, WS_R = 404 * MiB;
constexpr size_t WS_P = WS_R, WS_Y = WS_R, WS_A2 = WS_R + 145 * MiB, WS_U2 = WS_R + 162 * MiB, WS_MIX = WS_R + 222 * MiB, WS_HD = WS_R + 145 * MiB, WS_END = WS_R + 332 * MiB;
constexpr size_t WS_YP = WS_R + 72 * MiB;
constexpr size_t EDGE_EU = (size_t)68 * 4 * FF * 4;
constexpr int LDS_BYTES = 147456, LDS_X_OFF = 131072, LDS_MISC_OFF = 131072 + 4096;
constexpr size_t WS_BAR = 4096, CTL_ZERO_BYTES = 65536;

struct Params { const float* in[25]; float* out; unsigned char* ws; };
typedef const __attribute__((address_space(4))) Params* KP;
enum { I_X = 0, I_C, I_CTX, I_CCTX, I_WADA, I_BADA, I_WIN, I_RPB, I_SINK, I_MQN, I_MKVN, I_WUQ, I_WUKV, I_GQN, I_GKN, I_WOUT, I_LN1G, I_LN1B, I_WG, I_WU, I_CW, I_CB, I_WD, I_LN2G, I_LN2B };

__device__ __forceinline__ unsigned f2bf(float f) { unsigned u = __builtin_bit_cast(unsigned, f); return (u + 0x7fffu + ((u >> 16) & 1u)) >> 16; }
__device__ __forceinline__ unsigned pk2(float lo, float hi) { return f2bf(lo) | (f2bf(hi) << 16); }
__device__ __forceinline__ float bf2f(unsigned short b) { return __builtin_bit_cast(float, (unsigned)b << 16); }
__device__ __forceinline__ float wave_sum(float v, int lane) {
#pragma unroll
    for (int o = 1; o < 64; o <<= 1) v += bperm_(lane ^ o, v);
    return v;
}
#define LDS_WAIT() asm volatile("s_waitcnt lgkmcnt(0)" ::: "memory")


#define XB_TMO      128
#define XB_XCNT(j)  (256  + 64 * (j))
#define XB_XSUB(j)  (1280 + 64 * (j))
#define XB_XGEN(j)  (2304 + 64 * (j))
#define XB_TOP      3328
#define XB_TOPGEN   3392
#define XCD_BAR_WORDS 3456
#define XB_SPIN_CAP (1u << 22)
__device__ __forceinline__ unsigned xb_ld(unsigned* p)              { return __hip_atomic_load(p, __ATOMIC_RELAXED, __HIP_MEMORY_SCOPE_AGENT); }
__device__ __forceinline__ unsigned xb_add(unsigned* p, unsigned v) { return __hip_atomic_fetch_add(p, v, __ATOMIC_RELAXED, __HIP_MEMORY_SCOPE_AGENT); }
__device__ __forceinline__ unsigned xb_xcc_id() { return (unsigned)__builtin_amdgcn_s_getreg((3 << 11) | 20) & 0xFu; }
#define XB_SPIN(cond, bar) do { unsigned _sp = 0; while (cond) { __builtin_amdgcn_s_sleep(1); \
    if ((++_sp & 255u) == 0u) { if (xb_ld(&(bar)[XB_TMO])) break; if (_sp > XB_SPIN_CAP) { atomicAdd(&(bar)[XB_TMO], 1u); break; } } } } while (0)
struct XcdBarrier { unsigned* bar; unsigned x; volatile LAS unsigned* st; };
__device__ __forceinline__ XcdBarrier xcd_barrier_post(unsigned* bar, volatile LAS unsigned* st) {
    XcdBarrier b; b.bar = bar; b.x = xb_xcc_id(); b.st = st;
    if (threadIdx.x == 0) (void)xb_add(&bar[XB_XCNT(b.x)], 1u);
    return b;
}
__device__ __forceinline__ void xcd_barrier_complete(unsigned* bar, unsigned x, unsigned& nloc, unsigned& nx) {
    const unsigned G = gridDim.x * gridDim.y * gridDim.z;
    unsigned sum, cnt, mine, sp = 0u;
    for (;;) {
        sum = 0u; cnt = 0u; mine = 0u;
#pragma unroll
        for (unsigned j = 0; j < 16; ++j) { const unsigned c = xb_ld(&bar[XB_XCNT(j)]); sum += c; cnt += (c > 0u) ? 1u : 0u; mine = (j == x) ? c : mine; }
        if (sum == G) break;
        __builtin_amdgcn_s_sleep(1);
        if ((++sp & 255u) == 0u) { if (xb_ld(&bar[XB_TMO])) break; if (sp > XB_SPIN_CAP) { atomicAdd(&bar[XB_TMO], 1u); break; } }
    }
    nloc = mine > 0u ? mine : 1u; nx = cnt > 0u ? cnt : 1u;
}
__device__ __forceinline__ void xcd_barrier(const XcdBarrier& b, int wv) {
    asm volatile("s_waitcnt vmcnt(0)" ::: "memory");
    __syncthreads();
    if (wv == 0 && lane_id_() == 0) {
        unsigned* bar = b.bar; asm volatile("" : "+s"(bar)); unsigned bx_ = b.x; asm volatile("" : "+s"(bx_));
        __builtin_amdgcn_s_waitcnt(0);
        unsigned nloc = b.st[0], nx = b.st[1];
        if (nloc == 0u) { xcd_barrier_complete(bar, bx_, nloc, nx); b.st[0] = nloc; b.st[1] = nx; }
        const unsigned old = xb_add(&bar[XB_XSUB(bx_)], 1u);
        const unsigned gen = old / nloc;
        if (old + 1u == (gen + 1u) * nloc) {
            __builtin_amdgcn_fence(__ATOMIC_RELEASE, "agent");
            asm volatile("s_waitcnt vmcnt(0)" ::: "memory");
            const unsigned og = xb_add(&bar[XB_TOP], 1u);
            const unsigned tg = og / nx;
            if (og + 1u == (tg + 1u) * nx) xb_add(&bar[XB_TOPGEN], 1u);
            else XB_SPIN(xb_ld(&bar[XB_TOPGEN]) == tg, bar);
            __builtin_amdgcn_fence(__ATOMIC_ACQUIRE, "agent");
            xb_add(&bar[XB_XGEN(bx_)], 1u);
            asm volatile("s_waitcnt vmcnt(0)" ::: "memory");
        } else {
            XB_SPIN(xb_ld(&bar[XB_XGEN(bx_)]) == gen, bar);
            __builtin_amdgcn_fence(__ATOMIC_ACQUIRE, "agent");
            asm volatile("s_waitcnt vmcnt(0)" ::: "memory");
        }
    }
    __syncthreads();
}

__device__ __forceinline__ void tr_item(const float* W, int N, bf16* WT, int ldk, int koff, int drow0, int k0, int n0, LAS float* scr, int lane) {
#pragma unroll 8
    for (int i = 0; i < 32; ++i) { const int kk = 2 * i + (lane >> 5); scr[kk * 33 + (lane & 31)] = W[(size_t)(k0 + kk) * N + n0 + (lane & 31)]; }
    LDS_WAIT(); asm volatile("" ::: "memory");
    const int c = lane & 7;
#pragma unroll
    for (int j = 0; j < 4; ++j) { const int n = (lane >> 3) + 8 * j; const LAS float* s = scr + (8 * c) * 33 + n;
        v4u o; o.x = pk2(s[0 * 33], s[1 * 33]); o.y = pk2(s[2 * 33], s[3 * 33]); o.z = pk2(s[4 * 33], s[5 * 33]); o.w = pk2(s[6 * 33], s[7 * 33]);
        *(v4u*)(WT + (size_t)(drow0 + n) * ldk + koff + k0 + 8 * c) = o; }
    LDS_WAIT(); asm volatile("" ::: "memory");
}
__device__ __forceinline__ void sincos_rr(float ang, float& s, float& c) {
    const float k = rintf(ang * 0.15915494309189535f);
    float r = fmaf(-k, 6.2831855f, ang); r = fmaf(-k, -1.7484555e-7f, r);
    s = __sinf(r); c = __cosf(r);
}
__device__ __forceinline__ void p0_phase(KP p, unsigned char* lds, int wv) {
    asm volatile("" : "+s"(p));
    int tid = wv * 64 + lane_id_(); asm volatile("" : "+v"(tid)); const int lane = tid & 63, wave = tid >> 6;
    unsigned char* ws = p->ws;
    { const int gt = blockIdx.x * 512 + tid; float2* T128 = (float2*)(ws + WS_ROPE); float2* T64 = T128 + 64 * 32;
      if (gt < 64 * 32) { const int pos = gt >> 5, i = gt & 31; const float f = exp2f(-(float)i * (13.287712379549449f / 32.0f)); float s, c; sincos_rr((float)pos * f, s, c); T128[gt] = make_float2(c, s); }
      else if (gt < 64 * 32 + 64 * 16) { const int g2 = gt - 64 * 32; const int pos = g2 >> 4, i = g2 & 15; const float f = exp2f(-(float)i * (13.287712379549449f / 16.0f)); float s, c; sincos_rr((float)pos * f, s, c); T64[g2] = make_float2(c, s); } }
    { const int gt = blockIdx.x * 512 + tid, GT = gridDim.x * 512;
      for (int i = gt; i < 2 * 61440; i += GT) { const int l = i / 61440; int r = i % 61440; bf16* W = (bf16*)(ws + WS_WUP) + (size_t)l * UPN * UPK;
        int row, col; if (r < 768 * 16) { row = r >> 4; col = 384 + (r & 15) * 8; } else { r -= 768 * 16; row = 768 + r / 48; col = (r % 48) * 8; }
        *(v4u*)(W + (size_t)row * UPK + col) = (v4u){0u, 0u, 0u, 0u}; } }
    { float* sv = (float*)lds; float* red = sv + 5 * 2048;
      for (int i = tid; i < 5 * 2048; i += 512) { const int v = i >> 11, k = i & 2047; const float x = v < 4 ? p->in[I_C][v * 2048 + k] : p->in[I_CCTX][k]; sv[i] = x / (1.0f + __expf(-x)); }
      __syncthreads();
      float* mod = (float*)(ws + WS_MOD);
      for (int item = blockIdx.x; item < 768; item += gridDim.x) {
        const int l = item / 384, n0 = (item % 384) * 32, col = tid & 31, kq = tid >> 5;
        const float* W = p->in[I_WADA] + (size_t)l * 2048 * 12288 + n0 + col;
        float acc[5] = {0.f, 0.f, 0.f, 0.f, 0.f};
        for (int k = kq * 128; k < kq * 128 + 128; k += 8) { float w[8];
#pragma unroll
          for (int u = 0; u < 8; ++u) w[u] = W[(size_t)(k + u) * 12288];
#pragma unroll
          for (int u = 0; u < 8; ++u)
#pragma unroll
            for (int v = 0; v < 5; ++v) acc[v] = fmaf(sv[v * 2048 + k + u], w[u], acc[v]); }
#pragma unroll
        for (int v = 0; v < 5; ++v) red[(kq * 5 + v) * 32 + col] = acc[v];
        __syncthreads();
        if (tid < 160) { const int v = tid >> 5, cc = tid & 31; float sacc = 0.f;
#pragma unroll
          for (int q = 0; q < 16; ++q) sacc += red[(q * 5 + v) * 32 + cc];
          mod[(size_t)(l * 5 + v) * 12288 + n0 + cc] = sacc + p->in[I_BADA][l * 12288 + n0 + cc]; }
        __syncthreads();
      } }
    { LAS float* scr = (LAS float*)((LAS unsigned char*)lds + 65536 + wave * 8704);
      const int gw = blockIdx.x * 8 + wave, NGW = gridDim.x * 8;
      constexpr int I_IN = 32 * 130, I_OUT = 32 * 64, I_G = 32 * 176, I_U = 32 * 176, I_DN = 88 * 64, I_UQ = 6 * 24, I_UKV = 2 * 32, I_L = I_IN + I_OUT + I_G + I_U + I_DN + I_UQ + I_UKV;
      for (int it = gw; it < 2 * I_L; it += NGW) {
        const int l = it / I_L; int r = it % I_L;
        if (r < I_IN) { const int kb = r / 130, nb = r % 130; tr_item(p->in[I_WIN] + (size_t)l * DM * INC, INC, (bf16*)(ws + WS_WIN) + (size_t)l * INP * DM, DM, 0, nb * 32, kb * 64, nb * 32, scr, lane); continue; } r -= I_IN;
        if (r < I_OUT) { const int kb = r / 64, nb = r % 64; tr_item(p->in[I_WOUT] + (size_t)l * DM * DM, DM, (bf16*)(ws + WS_WOUT) + (size_t)l * DM * DM, DM, 0, nb * 32, kb * 64, nb * 32, scr, lane); continue; } r -= I_OUT;
        if (r < I_G) { const int kb = r / 176, nb = r % 176, n0 = nb * 32; tr_item(p->in[I_WG] + (size_t)l * DM * FF, FF, (bf16*)(ws + WS_WGU) + (size_t)l * 2 * FF * DM, DM, 0, (n0 >> 7) * 256 + (n0 & 127), kb * 64, n0, scr, lane); continue; } r -= I_G;
        if (r < I_U) { const int kb = r / 176, nb = r % 176, n0 = nb * 32; tr_item(p->in[I_WU] + (size_t)l * DM * FF, FF, (bf16*)(ws + WS_WGU) + (size_t)l * 2 * FF * DM, DM, 0, (n0 >> 7) * 256 + 128 + (n0 & 127), kb * 64, n0, scr, lane); continue; } r -= I_U;
        if (r < I_DN) { const int kb = r / 64, nb = r % 64; tr_item(p->in[I_WD] + (size_t)l * FF * DM, DM, (bf16*)(ws + WS_WDN) + (size_t)l * DM * FF, FF, 0, nb * 32, kb * 64, nb * 32, scr, lane); continue; } r -= I_DN;
        if (r < I_UQ) { const int kb = r / 24, nb = r % 24; tr_item(p->in[I_WUQ] + (size_t)l * 384 * 768, 768, (bf16*)(ws + WS_WUP) + (size_t)l * UPN * UPK, UPK, 0, nb * 32, kb * 64, nb * 32, scr, lane); continue; } r -= I_UQ;
        { const int kb = r / 32, nb = r % 32; tr_item(p->in[I_WUKV] + (size_t)l * 128 * 1024, 1024, (bf16*)(ws + WS_WUP) + (size_t)l * UPN * UPK, UPK, 384, 768 + nb * 32, kb * 64, nb * 32, scr, lane); }
      } }
}

typedef _Float16 h16x4 __attribute__((ext_vector_type(4)));
__device__ __forceinline__ void ln_mod_store(const f32x4 (&v)[8], const float* shift, const float* scale, bf16* hrow, int lane) {
    float s = 0.f;
#pragma unroll
    for (int j = 0; j < 8; ++j) s += (v[j].x + v[j].y) + (v[j].z + v[j].w);
    const float mean = wave_sum(s, lane) * (1.f / DM); float s2 = 0.f;
#pragma unroll
    for (int j = 0; j < 8; ++j) { const f32x4 d = v[j] - mean; s2 += (d.x * d.x + d.y * d.y) + (d.z * d.z + d.w * d.w); }
    const float rstd = 1.0f / sqrtf(wave_sum(s2, lane) * (1.f / DM) + EPS);
#pragma unroll
    for (int j = 0; j < 8; ++j) { const int c = 4 * (64 * j + lane); const f32x4 sh = *(const f32x4*)(shift + c), sc = *(const f32x4*)(scale + c);
        const f32x4 y = (v[j] - mean) * rstd * (sc + 1.0f) + sh;
        v2u w; w.x = pk2(y.x, y.y); w.y = pk2(y.z, y.w); *(v2u*)(hrow + c) = w; }
}
__device__ __forceinline__ void modulate0_phase(KP p, int wv, unsigned char* lds) {
    asm volatile("" : "+s"(p));
    int tid_ = wv * 64 + lane_id_(); asm volatile("" : "+v"(tid_)); const int lane = tid_ & 63, wave = wv; const int gw = blockIdx.x * 8 + wave, NGW = gridDim.x * 8;
    const float* mod = (const float*)(p->ws + WS_MOD); bf16* H = (bf16*)(p->ws + WS_H);
    LAS float* Lw = (LAS float*)(LAS unsigned char*)lds;
    for (int i = tid_; i < 5 * 1024; i += 512) { const int v = i >> 10, c = 4 * (i & 1023); *(LAS f32x4*)(Lw + 4096 * v + c) = *(const f32x4*)(mod + (size_t)v * 12288 + c); }
    __syncthreads();
    const LAS float* L = Lw;
    for (int m0 = gw; m0 < MTOT; m0 += 2 * NGW) {
        f32x4 x[2][8];
#pragma unroll
        for (int r = 0; r < 2; ++r) { const int m = m0 + r * NGW; if (m >= MTOT) break;
            const float* xr = m < NLAT ? p->in[I_X] + (size_t)m * DM : p->in[I_CTX] + (size_t)(m - NLAT) * DM;
#pragma unroll
            for (int j = 0; j < 8; ++j) { const int c = 4 * (64 * j + lane); x[r][j] = *(const f32x4*)(xr + c);
                *(h16x4*)((_Float16*)(p->ws + WS_X) + (size_t)m * DM + c) = __builtin_convertvector(x[r][j], h16x4); } }
#pragma unroll
        for (int r = 0; r < 2; ++r) { const int m = m0 + r * NGW; if (m >= MTOT) break; const int v = m < NLAT ? (m >> 12) : 4;
            float s = 0.f;
#pragma unroll
            for (int j = 0; j < 8; ++j) s += (x[r][j].x + x[r][j].y) + (x[r][j].z + x[r][j].w);
            const float mean = wave_sum(s, lane) * (1.f / DM); float s2 = 0.f;
#pragma unroll
            for (int j = 0; j < 8; ++j) { const f32x4 d = x[r][j] - mean; s2 += (d.x * d.x + d.y * d.y) + (d.z * d.z + d.w * d.w); }
            const float rstd = 1.0f / sqrtf(wave_sum(s2, lane) * (1.f / DM) + EPS);
#pragma unroll
            for (int j = 0; j < 8; ++j) { const int c = 4 * (64 * j + lane); const f32x4 sh = *(const LAS f32x4*)(L + 4096 * v + c), sc = *(const LAS f32x4*)(L + 4096 * v + 2048 + c);
                const f32x4 y = (x[r][j] - mean) * rstd * (sc + 1.0f) + sh;
                v2u w; w.x = pk2(y.x, y.y); w.y = pk2(y.z, y.w); *(v2u*)(H + (size_t)m * DM + c) = w; } }
    }
    __syncthreads();
}
__device__ __forceinline__ f32x4 bf4(v2u w) { return (f32x4){__builtin_bit_cast(float, w.x << 16), __builtin_bit_cast(float, w.x & 0xffff0000u), __builtin_bit_cast(float, w.y << 16), __builtin_bit_cast(float, w.y & 0xffff0000u)}; }
constexpr int RP_LG = 0, RP_LB = 2048, RP_V0 = 4096, RP_VS = 6144;
template <int NR, bool PART>
__device__ __forceinline__ void rowpass_rows(KP p, int l, int which, int mbeg, int mend, int wv, unsigned char* lds) {
    int tid_ = wv * 64 + lane_id_(); asm volatile("" : "+v"(tid_)); const int lane = tid_ & 63, wave = wv;     const int gw = blockIdx.x * 8 + wave, NGW = gridDim.x * 8;
    const float* mod = (const float*)(p->ws + WS_MOD); bf16* H = (bf16*)(p->ws + WS_H); _Float16* X = (_Float16*)(p->ws + WS_X); const bf16* Y = (const bf16*)(p->ws + WS_Y);
    const float* lg = p->in[which == 1 ? I_LN1G : I_LN2G] + l * DM; const float* lb = p->in[which == 1 ? I_LN1B : I_LN2B] + l * DM;
    const bool last = (l == 1 && which == 2);
    const LAS float* L = (const LAS float*)(LAS unsigned char*)lds;
    {
        LAS float* Lw = (LAS float*)(LAS unsigned char*)lds;
        { const int c = 4 * tid_; const f32x4 a = *(const f32x4*)(lg + c), b = *(const f32x4*)(lb + c); *(LAS f32x4*)(Lw + RP_LG + c) = a; *(LAS f32x4*)(Lw + RP_LB + c) = b; }
        constexpr int NV = PART ? 1 : 4;
        f32x4 gt[NV], s1[NV], s2[NV]; const int c = 4 * tid_;
#pragma unroll
        for (int v = 0; v < NV; ++v) { const int vr = PART ? 4 : v;
            gt[v] = *(const f32x4*)(mod + (size_t)(l * 5 + vr) * 12288 + (which == 1 ? 2 : 5) * DM + c);
            const float* sh = which == 1 ? mod + (size_t)(l * 5 + vr) * 12288 + 3 * DM : mod + (size_t)((l == 1 ? 1 : l + 1) * 5 + vr) * 12288 + 0 * DM;
            s1[v] = *(const f32x4*)(sh + c); s2[v] = *(const f32x4*)(sh + DM + c); }
#pragma unroll
        for (int v = 0; v < NV; ++v) { *(LAS f32x4*)(Lw + RP_V0 + RP_VS * v + c) = gt[v]; *(LAS f32x4*)(Lw + RP_V0 + RP_VS * v + 2048 + c) = s1[v]; *(LAS f32x4*)(Lw + RP_V0 + RP_VS * v + 4096 + c) = s2[v]; }
        __syncthreads();
    }
    for (int m0 = mbeg + gw; m0 < mend; m0 += NR * NGW) {
        f32x4 z[NR][8];
#pragma unroll
        for (int r = 0; r < NR; ++r) { const int m = m0 + r * NGW; if (m >= mend) break; const int v = PART ? 0 : (m >> 12);
            const _Float16* xh = X + (size_t)m * DM;
            const bf16* yr = PART ? (const bf16*)(p->ws + WS_YP) + (size_t)(m - NLAT) * DM : Y + (size_t)m * DM;
            if constexpr (PART) {
                v2u yw[4][8]; h16x4 xw[8];
#pragma unroll
                for (int j = 0; j < 8; ++j) { const int c = 4 * (64 * j + lane);
#pragma unroll
                    for (int ks = 0; ks < 4; ++ks) yw[ks][j] = *(const v2u*)(yr + (size_t)ks * 1024 * DM + c);
                    xw[j] = *(const h16x4*)(xh + c); }
#pragma unroll
                for (int j = 0; j < 8; ++j) { const int c = 4 * (64 * j + lane); const f32x4 yv = (bf4(yw[0][j]) + bf4(yw[1][j])) + (bf4(yw[2][j]) + bf4(yw[3][j]));
                    z[r][j] = __builtin_convertvector(xw[j], f32x4) * ALPHA + *(const LAS f32x4*)(L + RP_V0 + c) * yv; }
            } else {
#pragma unroll
                for (int j = 0; j < 8; ++j) { const int c = 4 * (64 * j + lane); const f32x4 yv = bf4(*(const v2u*)(yr + c));
                    const f32x4 xv = __builtin_convertvector(*(const h16x4*)(xh + c), f32x4);
                    const f32x4 gv = *(const LAS f32x4*)(L + RP_V0 + RP_VS * v + c);
                    z[r][j] = xv * ALPHA + gv * yv; } } }
#pragma unroll
        for (int r = 0; r < NR; ++r) { const int m = m0 + r * NGW; if (m >= mend) break; const int v = PART ? 0 : (m >> 12);
            float s = 0.f;
#pragma unroll
            for (int j = 0; j < 8; ++j) s += (z[r][j].x + z[r][j].y) + (z[r][j].z + z[r][j].w);
            const float mean = wave_sum(s, lane) * (1.f / DM); float s2 = 0.f;
#pragma unroll
            for (int j = 0; j < 8; ++j) { const f32x4 d = z[r][j] - mean; s2 += (d.x * d.x + d.y * d.y) + (d.z * d.z + d.w * d.w); }
            const float rstd = 1.0f / sqrtf(wave_sum(s2, lane) * (1.f / DM) + EPS);
            float* xo = p->out + (size_t)m * DM; _Float16* xoh = X + (size_t)m * DM;
            if constexpr (PART) asm volatile("" ::: "memory");
#pragma unroll
            for (int j = 0; j < 8; ++j) { const int c = 4 * (64 * j + lane);
                const f32x4 gg = *(const LAS f32x4*)(L + RP_LG + c), bb = *(const LAS f32x4*)(L + RP_LB + c);
                z[r][j] = (z[r][j] - mean) * rstd * gg + bb;
                if (last) *(f32x4*)(xo + c) = z[r][j]; else *(h16x4*)(xoh + c) = __builtin_convertvector(z[r][j], h16x4); }
            if (!last) {
                {
                    float t = 0.f;
#pragma unroll
                    for (int j = 0; j < 8; ++j) t += (z[r][j].x + z[r][j].y) + (z[r][j].z + z[r][j].w);
                    const float mean2 = wave_sum(t, lane) * (1.f / DM); float t2 = 0.f;
#pragma unroll
                    for (int j = 0; j < 8; ++j) { const f32x4 d = z[r][j] - mean2; t2 += (d.x * d.x + d.y * d.y) + (d.z * d.z + d.w * d.w); }
                    const float rstd2 = 1.0f / sqrtf(wave_sum(t2, lane) * (1.f / DM) + EPS);
                    if constexpr (PART) asm volatile("" ::: "memory");
#pragma unroll
                    for (int j = 0; j < 8; ++j) { const int c = 4 * (64 * j + lane); const f32x4 shv = *(const LAS f32x4*)(L + RP_V0 + RP_VS * v + 2048 + c), scv = *(const LAS f32x4*)(L + RP_V0 + RP_VS * v + 4096 + c);
                        const f32x4 y = (z[r][j] - mean2) * rstd2 * (scv + 1.0f) + shv;
                        v2u w; w.x = pk2(y.x, y.y); w.y = pk2(y.z, y.w); *(v2u*)(H + (size_t)m * DM + c) = w; }
                } } }
    }
    __syncthreads();
}
__device__ __forceinline__ void rowpass_phase(KP p, int l, int which, int M, int wv, unsigned char* lds) {
    asm volatile("" : "+s"(p));
    rowpass_rows<2, false>(p, l, which, 0, NLAT, wv, lds);
    if (M > NLAT) { asm volatile("" : "+s"(p)); rowpass_rows<1, true>(p, l, which, NLAT, M, wv, lds); }
}
__device__ __forceinline__ float half_sum(float v, int lane) {
#pragma unroll
    for (int o = 1; o < 32; o <<= 1) v += bperm_(lane ^ o, v);
    return v;
}
__device__ __forceinline__ void prep_phase(KP p, int l, int wv) {
    asm volatile("" : "+s"(p));
    int tid_ = wv * 64 + lane_id_(); asm volatile("" : "+v"(tid_)); const int lane = tid_ & 63, wave = wv; const int gw = blockIdx.x * 8 + wave, NGW = gridDim.x * 8;
    bf16* P = (bf16*)(p->ws + WS_P); bf16* A2 = (bf16*)(p->ws + WS_A2);
    const float2* T128 = (const float2*)(p->ws + WS_ROPE); const float2* T64 = T128 + 64 * 32;
    const float* gq = p->in[I_GQN] + l * 128; const float* gk = p->in[I_GKN] + l * 128; const float* mq = p->in[I_MQN] + l * 384; const float* mkv = p->in[I_MKVN] + l * 128;
    const int hs = lane >> 5, li = lane & 31, hf = li >> 4, i0 = 2 * (li & 15), e1 = 64 * hf + i0, e2 = e1 + 32;
    const float gq0 = gq[e1], gq1 = gq[e1 + 1], gq2 = gq[e2], gq3 = gq[e2 + 1], gk0 = gk[e1], gk1 = gk[e1 + 1], gk2 = gk[e2], gk3 = gk[e2 + 1];
    float mqr[6];
#pragma unroll
    for (int k = 0; k < 3; ++k) { mqr[2 * k] = mq[2 * lane + 128 * k]; mqr[2 * k + 1] = mq[2 * lane + 128 * k + 1]; }
    const float mkv0 = mkv[2 * lane], mkv1 = mkv[2 * lane + 1];
    for (int m = gw; m < MTOT; m += NGW) {
        bf16* pr = P + (size_t)m * INP; const bool isctx = m >= NLAT; const int t = m & 4095, grow = t >> 6, gcol = t & 63;
        float c0 = 1.f, s0 = 0.f, c1 = 1.f, s1 = 0.f;
        if (!isctx) { const float2 a = T128[(hf ? gcol : grow) * 32 + i0], b = T128[(hf ? gcol : grow) * 32 + i0 + 1]; c0 = a.x; s0 = a.y; c1 = b.x; s1 = b.y; }
        if (!isctx) {
#pragma unroll
            for (int hh = 0; hh < 3; ++hh) { const int h = 2 * hh + hs; bf16* hp = pr + (h < 4 ? 1536 + h * 128 : 2048 + (h - 4) * 128);
                const unsigned w1 = *(const unsigned*)(hp + e1), w2 = *(const unsigned*)(hp + e2);
                const float x1a = __builtin_bit_cast(float, w1 << 16), x1b = __builtin_bit_cast(float, w1 & 0xffff0000u), x2a = __builtin_bit_cast(float, w2 << 16), x2b = __builtin_bit_cast(float, w2 & 0xffff0000u);
                *(unsigned*)(hp + e1) = pk2(x1a * c0 - x2a * s0, x1b * c1 - x2b * s1); *(unsigned*)(hp + e2) = pk2(x2a * c0 + x1a * s0, x2b * c1 + x1b * s1); }
        }
#pragma unroll
        for (int hh = 0; hh < 3; ++hh) { const int h = 2 * hh + hs; bf16* hp = pr + (h < 4 ? 3136 + h * 128 : 3648 + (h - 4) * 128);
            const unsigned w1 = *(const unsigned*)(hp + e1), w2 = *(const unsigned*)(hp + e2);
            float x1a = __builtin_bit_cast(float, w1 << 16), x1b = __builtin_bit_cast(float, w1 & 0xffff0000u), x2a = __builtin_bit_cast(float, w2 << 16), x2b = __builtin_bit_cast(float, w2 & 0xffff0000u);
            const float ss = half_sum((x1a * x1a + x1b * x1b) + (x2a * x2a + x2b * x2b), lane); const float rstd = 1.0f / sqrtf(ss * (1.f / 128.f) + EPS);
            x1a *= rstd * (h < 4 ? gq0 : gk0); x1b *= rstd * (h < 4 ? gq1 : gk1); x2a *= rstd * (h < 4 ? gq2 : gk2); x2b *= rstd * (h < 4 ? gq3 : gk3);
            *(unsigned*)(hp + e1) = pk2(x1a * c0 - x2a * s0, x1b * c1 - x2b * s1); *(unsigned*)(hp + e2) = pk2(x2a * c0 + x1a * s0, x2b * c1 + x1b * s1); }
        { float xv[6]; float ss = 0.f;
#pragma unroll
          for (int k = 0; k < 3; ++k) { const unsigned w = *(const unsigned*)(pr + 2560 + 2 * lane + 128 * k); xv[2 * k] = __builtin_bit_cast(float, w << 16); xv[2 * k + 1] = __builtin_bit_cast(float, w & 0xffff0000u); ss += xv[2 * k] * xv[2 * k] + xv[2 * k + 1] * xv[2 * k + 1]; }
          const float rstd = 1.0f / sqrtf(wave_sum(ss, lane) * (1.f / 384.f) + EPS);
#pragma unroll
          for (int k = 0; k < 3; ++k) { const int e = 2 * lane + 128 * k; *(unsigned*)(A2 + (size_t)m * UPK + e) = pk2(xv[2 * k] * rstd * mqr[2 * k], xv[2 * k + 1] * rstd * mqr[2 * k + 1]); } }
        { const unsigned w = *(const unsigned*)(pr + 2944 + 2 * lane); const float x1 = __builtin_bit_cast(float, w << 16), x2 = __builtin_bit_cast(float, w & 0xffff0000u);
          const float rstd = 1.0f / sqrtf(wave_sum(x1 * x1 + x2 * x2, lane) * (1.f / 128.f) + EPS);
          *(unsigned*)(A2 + (size_t)m * UPK + 384 + 2 * lane) = pk2(x1 * rstd * mkv0, x2 * rstd * mkv1); }
        if (!isctx && lane < 32) { const int hf2 = lane >> 4, i16 = lane & 15; const float2 cs = T64[(hf2 ? gcol : grow) * 16 + i16];
            bf16* hp = pr + 3072 + hf2 * 32 + i16; const float x1 = bf2f(hp[0]), x2 = bf2f(hp[16]); hp[0] = (bf16)f2bf(x1 * cs.x - x2 * cs.y); hp[16] = (bf16)f2bf(x2 * cs.x + x1 * cs.y); }
    }
}
__device__ __forceinline__ void qpe_phase(KP p, int wv) {
    int tid_ = wv * 64 + lane_id_(); asm volatile("" : "+v"(tid_)); const int lane = tid_ & 63, wave = tid_ >> 6; const int gw = blockIdx.x * 8 + wave, NGW = gridDim.x * 8;
    bf16* U2 = (bf16*)(p->ws + WS_U2); const float2* T64 = (const float2*)(p->ws + WS_ROPE) + 64 * 32;
    const int hsel = lane >> 5, l32 = lane & 31, hf = l32 >> 4, i16 = l32 & 15;
    for (int m = gw; m < NLAT; m += NGW) { const int t = m & 4095, grow = t >> 6, gcol = t & 63; const float2 cs = T64[(hf ? gcol : grow) * 16 + i16];
#pragma unroll
        for (int hh = 0; hh < 2; ++hh) { bf16* hp = U2 + (size_t)m * UPN + (2 * hh + hsel) * 192 + 128 + hf * 32 + i16;
            const float x1 = bf2f(hp[0]), x2 = bf2f(hp[16]); hp[0] = (bf16)f2bf(x1 * cs.x - x2 * cs.y); hp[16] = (bf16)f2bf(x2 * cs.x + x1 * cs.y); } }
}
__device__ __forceinline__ void fixup_phase(KP p, int l, int ntile, int wv) {
    asm volatile("" : "+s"(p));
    int tid_ = wv * 64 + lane_id_(); asm volatile("" : "+v"(tid_)); const int lane = tid_ & 63, wave = tid_ >> 6; const int gw = blockIdx.x * 8 + wave, NGW = gridDim.x * 8;
    bf16* HD = (bf16*)(p->ws + WS_HD); const float* Eg = (const float*)(p->ws + WS_EDGE); const float* Eu = (const float*)(p->ws + WS_EDGE + EDGE_EU);
    const float* cw = p->in[I_CW] + (size_t)l * 3 * FF; const float* cb = p->in[I_CB] + (size_t)l * FF;
    for (int it = gw; it < ntile * 2 * 22; it += NGW) { const int seg = it % 22, rw = (it / 22) & 1, pm = it / 44;
        const bool lat = pm < 64; const bool sstart = lat ? ((pm & 15) == 0) : true, send = lat ? ((pm & 15) == 15) : true;
        const int ch = seg * 256 + lane * 4;
        f32x4 gp, gc, gn, uu;
        if (rw == 0) { gp = sstart ? (f32x4){0.f, 0.f, 0.f, 0.f} : *(const f32x4*)(Eg + (size_t)((pm - 1) * 4 + 3) * FF + ch); gc = *(const f32x4*)(Eg + (size_t)(pm * 4 + 0) * FF + ch); gn = *(const f32x4*)(Eg + (size_t)(pm * 4 + 1) * FF + ch); uu = *(const f32x4*)(Eu + (size_t)(pm * 2 + 0) * FF + ch); }
        else { gp = *(const f32x4*)(Eg + (size_t)(pm * 4 + 2) * FF + ch); gc = *(const f32x4*)(Eg + (size_t)(pm * 4 + 3) * FF + ch); gn = send ? (f32x4){0.f, 0.f, 0.f, 0.f} : *(const f32x4*)(Eg + (size_t)((pm + 1) * 4 + 0) * FF + ch); uu = *(const f32x4*)(Eu + (size_t)(pm * 2 + 1) * FF + ch); }
        const f32x4 a = *(const f32x4*)(cw + ch) * gp + *(const f32x4*)(cw + FF + ch) * gc + *(const f32x4*)(cw + 2 * FF + ch) * gn + *(const f32x4*)(cb + ch);
        f32x4 h;
#pragma unroll
        for (int j = 0; j < 4; ++j) h[j] = a[j] / (1.0f + __expf(-a[j])) * uu[j];
        v2u w; w.x = pk2(h[0], h[1]); w.y = pk2(h[2], h[3]);
        *(v2u*)(HD + (size_t)(pm * 256 + (rw ? 255 : 0)) * FF + ch) = w; }
}
__device__ __forceinline__ void attn_phase(KP p, int l, unsigned char* lds, int wv) {
    asm volatile("" : "+s"(p));
    const bf16* P = (const bf16*)(p->ws + WS_P); const bf16* U2 = (const bf16*)(p->ws + WS_U2); bf16* MIX = (bf16*)(p->ws + WS_MIX);
    for (int v = blockIdx.x; v < 256; v += gridDim.x) {
        const int pair = v & 7, idx = v >> 3; const int nun = (l == 0 && v < 64) ? 5 : 4;
        for (int ui = 0; ui < nun; ++ui) {
            int b, h, qb, grp; bool cq = false;
            if (ui < 4) { b = pair >> 1; h = (pair & 1) * 2 + (idx >> 4); qb = idx & 15; grp = (ui == 0) ? 2 : (ui == 1) ? 3 : (ui == 2) ? 0 : 1; }
            else { b = v >> 4; grp = (v >> 2) & 3; h = v & 3; qb = 0; cq = true; }
            att::AttnArgs a; a.Q2 = nullptr; a.KR = nullptr; a.ldkr = INP; a.ldo = DM; a.has_sink = 0; a.sinkp = nullptr; a.rpb = nullptr;
            a.ctxrow0 = NLAT + b * CTX; a.qpos0 = qb * 256; a.qrow0 = cq ? NLAT + b * CTX : b * SEQ + qb * 256; a.wstart = 0; a.NT = cq ? 4 : 68;
            a.O = MIX + grp * 512 + h * 128;
            if (grp == 0) { a.Q = P + h * 128; a.K = P + 512 + h * 128; a.V = P + 1024 + h * 128; a.ldq = a.ldk = a.ldv = INP;
                if (!cq) { a.wstart = 64 * min(max(4 * qb - 4, 0), 52); a.NT = 16; a.rpb = p->in[I_RPB] + (size_t)(l * 4 + h) * 465; } }
            else if (grp == 1) { a.Q = P + 1536 + h * 128; a.K = P + 2048 + (h >> 1) * 128; a.V = P + 2304 + (h >> 1) * 128; a.ldq = a.ldk = a.ldv = INP;
                a.has_sink = 1; a.sinkp = p->in[I_SINK] + l * 4 + h;
                if (!cq) { a.wstart = min(max(256 * qb - 128, 0), SEQ - 512); a.NT = 12; } }
            else if (grp == 2) { a.Q = U2 + h * 192; a.Q2 = U2 + h * 192 + 128; a.K = U2 + 768 + h * 256; a.V = U2 + 768 + h * 256 + 128; a.KR = P + 3072; a.ldq = a.ldk = a.ldv = UPN; }
            else { a.Q = P + 3136 + h * 128; a.K = P + 3648 + (h >> 1) * 128; a.V = P + 3904 + (h >> 1) * 128; a.ldq = a.ldk = a.ldv = INP; }
            a.latrow0 = b * SEQ + a.wstart;
            if (grp == 2) att::attn_unit<0, true>(a, (char*)lds, wv);
            else if (grp == 0 && !cq) att::attn_unit<1, false>(a, (char*)lds, wv);
            else if (grp == 1 && !cq) att::attn_unit<2, false>(a, (char*)lds, wv);
            else att::attn_unit<0, false>(a, (char*)lds, wv);
        }
    }
}

__global__ void __launch_bounds__(512, 2) mk_fwd(Params p_unused) {
    extern __shared__ __attribute__((aligned(16))) unsigned char lds[];
    cg::grid_group grid = cg::this_grid();
    PG8_LAS unsigned char* ldsl = (PG8_LAS unsigned char*)lds;
    KP p = (KP)__builtin_amdgcn_kernarg_segment_ptr();
#define RELOAD() asm volatile("" : "+s"(p)); unsigned char* ws = p->ws
    const int G = gridDim.x, bx = blockIdx.x;
    const int wv = __builtin_amdgcn_readfirstlane((int)(threadIdx.x >> 6));
    volatile LAS unsigned* misc = (volatile LAS unsigned*)((LAS unsigned char*)lds + LDS_MISC_OFF);
    if (threadIdx.x < 16) misc[threadIdx.x] = 0u;
    __syncthreads();
    const XcdBarrier bar = xcd_barrier_post((unsigned*)(p->ws + WS_BAR), misc);
#define GSYNC() xcd_barrier(bar, wv)
    p0_phase(p, lds, wv);
    if (__builtin_expect(G == 0x7fffffff, 0)) grid.sync();
    GSYNC();
    modulate0_phase(p, wv, lds);
    GSYNC();
#pragma unroll 1
    for (int l = 0; l < 2; ++l) {
        const int M2 = (l == 0) ? MTOT : NLAT;
        { RELOAD(); pg8::Gemm g{(const bf16*)(ws + WS_H), (const bf16*)(ws + WS_WIN) + (size_t)l * INP * DM + (size_t)256 * DM, MTOT, INP - 512, DM, DM, DM}; pg8::StaticOrder S; S.init(MTOT, INP - 512, G, bx);
          pg8::EpiBf16 E{(bf16*)(ws + WS_P) + 256, INP}; pg8::gemm_phase<pg8::EpiBf16, pg8::StaticOrder, true, true>(ldsl, g, S, E, wv); }
        GSYNC();
        prep_phase(p, l, wv);
        GSYNC();
        { RELOAD(); constexpr int NBIG = 2 * (MTOT / 256);
          { pg8::Gemm g{(const bf16*)(ws + WS_H), (const bf16*)(ws + WS_WIN) + (size_t)l * INP * DM, MTOT, INP, DM, DM, DM}; pg8::ColOrder S{MTOT / 256, G, bx};
            pg8::EpiBf16 E{(bf16*)(ws + WS_P), INP}; pg8::gemm_phase<pg8::EpiBf16, pg8::ColOrder, true, true>(ldsl, g, S, E, wv); }
          { pg8::Gemm g{(const bf16*)(ws + WS_A2), (const bf16*)(ws + WS_WUP) + (size_t)l * UPN * UPK, MTOT, UPN, 256, UPK, UPK};
            pg8::UpOrder S{MTOT / 256, (G > NBIG + 8) ? G - NBIG : G, (G > NBIG + 8) ? bx - NBIG : bx};
            pg8::EpiUp E{(bf16*)(ws + WS_U2), UPN, (const float2*)(ws + WS_ROPE) + 64 * 32, NLAT}; pg8::gemm_phase<pg8::EpiUp, pg8::UpOrder, true, true>(ldsl, g, S, E, wv); } }
        GSYNC();
        attn_phase(p, l, lds, wv);
        GSYNC();
        { RELOAD(); pg8::Gemm g{(const bf16*)(ws + WS_MIX), (const bf16*)(ws + WS_WOUT) + (size_t)l * DM * DM, NLAT, DM, DM, DM, DM}; pg8::StaticOrder S; S.init(NLAT, DM, G, bx);
          pg8::EpiBf16 E{(bf16*)(ws + WS_Y), DM}; pg8::gemm_phase<pg8::EpiBf16, pg8::StaticOrder, true, true>(ldsl, g, S, E, wv);
          if (l == 0) { pg8::Gemm g2{(const bf16*)(ws + WS_MIX), (const bf16*)(ws + WS_WOUT) + (size_t)l * DM * DM, MTOT, DM, DM / 4, DM, DM}; pg8::SplitOrder S2{64, 4, 8, 4, G, bx};
            pg8::EpiSplit E2{(bf16*)(ws + WS_YP), DM}; pg8::gemm_phase<pg8::EpiSplit, pg8::SplitOrder, true, true>(ldsl, g2, S2, E2, wv); } }
        GSYNC();
        rowpass_phase(p, l, 1, M2, wv, lds);
        GSYNC();
        { RELOAD(); pg8::Gemm g{(const bf16*)(ws + WS_H), (const bf16*)(ws + WS_WGU) + (size_t)l * 2 * FF * DM, M2, 2 * FF, DM, DM, DM}; pg8::StaticOrder S; S.init(M2, 2 * FF, G, bx);
          pg8::EpiConv E{(bf16*)(ws + WS_HD), p->in[I_CW] + (size_t)l * 3 * FF, p->in[I_CB] + (size_t)l * FF, (float*)(ws + WS_EDGE), (float*)(ws + WS_EDGE + EDGE_EU), (PG8_LAS float*)(ldsl + LDS_X_OFF), (PG8_LAS float*)(ldsl + LDS_X_OFF + 4096 + 256)};
          pg8::gemm_phase<pg8::EpiConv, pg8::StaticOrder, true, true>(ldsl, g, S, E, wv); }
        GSYNC();
        fixup_phase(p, l, M2 / 256, wv);
        GSYNC();
        { RELOAD(); pg8::Gemm g{(const bf16*)(ws + WS_HD), (const bf16*)(ws + WS_WDN) + (size_t)l * DM * FF, NLAT, DM, FF, FF, FF}; pg8::StaticOrder S; S.init(NLAT, DM, G, bx);
          pg8::EpiBf16 E{(bf16*)(ws + WS_Y), DM}; pg8::gemm_phase<pg8::EpiBf16, pg8::StaticOrder, true, true>(ldsl, g, S, E, wv);
          if (l == 0) { pg8::Gemm g2{(const bf16*)(ws + WS_HD), (const bf16*)(ws + WS_WDN) + (size_t)l * DM * FF, MTOT, DM, FF / 4, FF, FF}; pg8::SplitOrder S2{64, 4, 8, 4, G, bx};
            pg8::EpiSplit E2{(bf16*)(ws + WS_YP), DM}; pg8::gemm_phase<pg8::EpiSplit, pg8::SplitOrder, true, true>(ldsl, g2, S2, E2, wv); } }
        GSYNC();
        rowpass_phase(p, l, 2, M2, wv, lds);
        if (l == 0) GSYNC();
    }
}

extern "C" void kernel_launch(void* const* d_in, const int* in_sizes, int n_in, void* d_out, int out_size, void* d_ws, size_t ws_size, hipStream_t stream) {
    static int grid = 0;
    if (grid == 0) {
        int dev = 0, cus = 0, per_cu = 0;
        (void)hipGetDevice(&dev);
        (void)hipDeviceGetAttribute(&cus, hipDeviceAttributeMultiprocessorCount, dev);
        (void)hipFuncSetAttribute((const void*)mk_fwd, hipFuncAttributeMaxDynamicSharedMemorySize, LDS_BYTES);
        (void)hipOccupancyMaxActiveBlocksPerMultiprocessor(&per_cu, (const void*)mk_fwd, 512, LDS_BYTES);
        if (per_cu < 1) per_cu = 1;
        grid = cus * per_cu;
        if (n_in != 25 || ws_size < WS_END || out_size != NLAT * DM) { fprintf(stderr, "kernel_launch: unexpected shapes (n_in %d out %d ws %zu)\n", n_in, out_size, ws_size); grid = -1; }
    }
    if (grid < 0) return;
    Params p{};
    for (int i = 0; i < 25; ++i) p.in[i] = (const float*)d_in[i];
    p.out = (float*)d_out; p.ws = (unsigned char*)d_ws;
    (void)hipMemsetAsync(d_ws, 0, CTL_ZERO_BYTES, stream);
    void* args[] = {&p};
    hipError_t e = hipLaunchCooperativeKernel((const void*)mk_fwd, dim3(grid), dim3(512), args, LDS_BYTES, stream);
    if (e != hipSuccess) fprintf(stderr, "cooperative launch failed: %s (grid %d)\n", hipGetErrorString(e), grid);
}
```

```cpp
#include <hip/hip_runtime.h>
#include <hip/hip_cooperative_groups.h>
#include <cstdio>
#include <cstdint>
namespace cg = cooperative_groups;

__device__ __forceinline__ int lane_id_() { int r; asm volatile("v_mbcnt_lo_u32_b32 %0, -1, 0\n\tv_mbcnt_hi_u32_b32 %0, -1, %0" : "=v"(r)); return r; }

__device__ __forceinline__ float bperm_(int srclane, float v) { return __builtin_bit_cast(float, __builtin_amdgcn_ds_bpermute(srclane << 2, __builtin_bit_cast(int, v))); }

namespace pg8 {
#define PG8_LAS __attribute__((address_space(3)))
typedef unsigned short bf16_t;
typedef short bf16x8 __attribute__((ext_vector_type(8)));
typedef float f32x4 __attribute__((ext_vector_type(4)));
typedef unsigned u32x4 __attribute__((ext_vector_type(4)));
constexpr int BM = 256, BK = 64, HALF = 128, HTB = HALF * BK * 2, STAGE_BYTES = 8 * HTB, NXCD = 8, WGM = 8;

__host__ __device__ __forceinline__ int lds_byte(int r, int c) { const int st = (r >> 4) * 2 + (c >> 5), rr = r & 15, cc = c & 31, ob = rr * 64 + cc * 2; return st * 1024 + (ob ^ (((ob >> 9) & 1) << 5)); }
__host__ __device__ __forceinline__ void stage_rc(int b, int& R, int& C) { const int st = b / 1024, sb = b % 1024, swz = sb ^ (((sb >> 9) & 1) << 5); R = (st >> 1) * 16 + swz / 64; C = (st & 1) * 32 + (swz % 64) / 2; }
__host__ __device__ __forceinline__ int perm32(int rho) { const int n = rho >> 4, i = rho & 15; return 8 * (i >> 2) + 4 * n + (i & 3); }

struct Unit { int pm, pn, ks, nt; };
struct Gemm { const bf16_t* A; const bf16_t* Bt; int M, N, K, lda, ldb; };

struct StaticOrder {
    int nM, nN, nwg, G, c;
    __host__ __device__ void init(int M, int N, int G_, int c_) { nM = M / BM; nN = N / BM; nwg = nM * nN; G = G_; c = c_; }
    __host__ __device__ bool next(int i, Unit& u) const {
        if (c < 0) return false;
        const long L = (long)i * G + c; if (L >= nwg) return false;
        int wgid = (int)L; { const int q = nwg / NXCD, r = nwg % NXCD, xcd = wgid % NXCD, off = wgid / NXCD; wgid = (xcd < r ? xcd * (q + 1) : r * (q + 1) + (xcd - r) * q) + off; }
        const int nig = WGM * nN, gid = wgid / nig, fm = gid * WGM, gsz = (nM - fm) < WGM ? (nM - fm) : WGM;
        u.pm = fm + ((wgid % nig) % gsz); u.pn = (wgid % nig) / gsz; u.ks = 0; u.nt = 0; return true;
    }
    __device__ __forceinline__ void a_ready(const Unit&) const {}
    __device__ __forceinline__ void done(const Unit&) const {}
};

struct ColOrder {
    int nM, G, c;
    __device__ bool next(int i, Unit& u) const { const long L = (long)i * G + c; if (L >= 2L * nM) return false; u.pm = (int)(L % nM); u.pn = (L / nM) ? 16 : 0; u.ks = 0; u.nt = 0; return true; }
    __device__ __forceinline__ void a_ready(const Unit&) const {}
    __device__ __forceinline__ void done(const Unit&) const {}
};
struct UpOrder {
    int nM, G, c;
    __device__ bool next(int i, Unit& u) const { if (c < 0) return false; const long L = (long)i * G + c; if (L >= 7L * nM) return false;
        u.pn = (int)(L % 7); u.pm = (int)(L / 7); u.ks = u.pn < 3 ? 0 : 1; u.nt = u.pn < 3 ? 6 : 4; return true; }
    __device__ __forceinline__ void a_ready(const Unit&) const {}
    __device__ __forceinline__ void done(const Unit&) const {}
};
struct SplitOrder {
    int pm0, npm, nN, nks, G, c;
    __device__ bool next(int i, Unit& u) const { const long L = (long)i * G + c; if (L >= (long)npm * nN * nks) return false;
        const int l = (int)L; u.ks = l % nks; u.pn = (l / nks) % nN; u.pm = pm0 + l / (nks * nN); u.nt = 0; return true; }
    __device__ __forceinline__ void a_ready(const Unit&) const {}
    __device__ __forceinline__ void done(const Unit&) const {}
};
__device__ __forceinline__ unsigned cvt_pk_bf16(float lo, float hi) { unsigned r; asm volatile("v_cvt_pk_bf16_f32 %0, %1, %2" : "=v"(r) : "v"(lo), "v"(hi)); return r; }

struct EpiBf16 {
    static constexpr bool PERM = true, AFTER_DRAIN = false;
    bf16_t* O; int ldc;
    __device__ __forceinline__ void operator()(const f32x4 (&acc)[2][2][4][2], const Unit& u, int wr, int wc, int fr, int fq) const {
        const int row0 = u.pm * BM + wr * 64 + fr; const int col0 = u.pn * BM + wc * 32 + 8 * fq;
#pragma unroll
        for (int ai = 0; ai < 2; ++ai)
#pragma unroll
            for (int m = 0; m < 4; ++m) { bf16_t* rowp = O + (size_t)(row0 + ai * HALF + m * 16) * ldc + col0;
#pragma unroll
                for (int bj = 0; bj < 2; ++bj) { const f32x4 v0 = acc[ai][bj][m][0], v1 = acc[ai][bj][m][1];
                    u32x4 w; w.x = cvt_pk_bf16(v0[0], v0[1]); w.y = cvt_pk_bf16(v0[2], v0[3]); w.z = cvt_pk_bf16(v1[0], v1[1]); w.w = cvt_pk_bf16(v1[2], v1[3]);
                    *(u32x4*)(rowp + bj * HALF) = w; } }
    }
};

struct EpiUp {
    static constexpr bool PERM = true, AFTER_DRAIN = false;
    bf16_t* O; int ldc; const float2* T64; int nlat;
    __device__ __forceinline__ void operator()(const f32x4 (&acc)[2][2][4][2], const Unit& u, int wr, int wc, int fr, int fq) const {
        const int row0 = u.pm * BM + wr * 64 + fr; const int col0 = u.pn * BM + wc * 32 + 8 * fq;
#pragma unroll
        for (int bj = 0; bj < 2; ++bj) {
            const int cblk = u.pn * BM + bj * HALF + wc * 32;
            const bool isrope = (cblk < 768) && ((cblk % 192) >= 128) && (u.pm * BM < nlat);
            const int colsel = ((cblk % 192) - 128) >> 5;
#pragma unroll
            for (int ai = 0; ai < 2; ++ai)
#pragma unroll
                for (int m = 0; m < 4; ++m) { const int row = row0 + ai * HALF + m * 16;
                    f32x4 v0 = acc[ai][bj][m][0], v1 = acc[ai][bj][m][1];
                    if (isrope) { const int t = row & 4095; const int pos = colsel ? (t & 63) : (t >> 6); const float sgn = (fq & 2) ? 1.0f : -1.0f;
                        const float2* tb = T64 + pos * 16 + (8 * (fq & 1));
#pragma unroll
                        for (int j = 0; j < 4; ++j) { const float2 c0 = tb[j], c1 = tb[4 + j];
                            const float o0 = bperm_((fq * 16 + fr) ^ 32, v0[j]), o1 = bperm_((fq * 16 + fr) ^ 32, v1[j]);
                            v0[j] = v0[j] * c0.x + sgn * o0 * c0.y; v1[j] = v1[j] * c1.x + sgn * o1 * c1.y; } }
                    u32x4 w; w.x = cvt_pk_bf16(v0[0], v0[1]); w.y = cvt_pk_bf16(v0[2], v0[3]); w.z = cvt_pk_bf16(v1[0], v1[1]); w.w = cvt_pk_bf16(v1[2], v1[3]);
                    *(u32x4*)(O + (size_t)row * ldc + col0 + bj * HALF) = w; }
        }
    }
};
struct EpiSplit {
    static constexpr bool PERM = true, AFTER_DRAIN = false;
    bf16_t* O; int ldc;
    __device__ __forceinline__ void operator()(const f32x4 (&acc)[2][2][4][2], const Unit& u, int wr, int wc, int fr, int fq) const {
        const int row0 = (u.pm - 64) * BM + wr * 64 + fr; const int col0 = u.pn * BM + wc * 32 + 8 * fq; bf16_t* base = O + (size_t)u.ks * 1024 * ldc;
#pragma unroll
        for (int ai = 0; ai < 2; ++ai)
#pragma unroll
            for (int m = 0; m < 4; ++m) { bf16_t* rowp = base + (size_t)(row0 + ai * HALF + m * 16) * ldc + col0;
#pragma unroll
                for (int bj = 0; bj < 2; ++bj) { const f32x4 v0 = acc[ai][bj][m][0], v1 = acc[ai][bj][m][1];
                    u32x4 w; w.x = cvt_pk_bf16(v0[0], v0[1]); w.y = cvt_pk_bf16(v0[2], v0[3]); w.z = cvt_pk_bf16(v1[0], v1[1]); w.w = cvt_pk_bf16(v1[2], v1[3]);
                    *(u32x4*)(rowp + bj * HALF) = w; } }
    }
};
struct EpiF32 {
    static constexpr bool PERM = false, AFTER_DRAIN = false;
    float* O; int ldc;
    __device__ __forceinline__ void operator()(const f32x4 (&acc)[2][2][4][2], const Unit& u, int wr, int wc, int fr, int fq) const {
        const int row0 = u.pm * BM + wr * 64 + fr; const int col0 = u.pn * BM + wc * 32 + 4 * fq;
#pragma unroll
        for (int ai = 0; ai < 2; ++ai)
#pragma unroll
            for (int m = 0; m < 4; ++m) { float* rowp = O + (size_t)(row0 + ai * HALF + m * 16) * ldc + col0;
#pragma unroll
                for (int bj = 0; bj < 2; ++bj)
#pragma unroll
                    for (int n = 0; n < 2; ++n) *(f32x4*)(rowp + bj * HALF + n * 16) = acc[ai][bj][m][n]; }
    }
};
constexpr int FFC = 5632;
struct EpiConv {
    static constexpr bool PERM = true, AFTER_DRAIN = false;
    bf16_t* HD; const float* cw; const float* cb; float* Eg; float* Eu; PG8_LAS float* X; PG8_LAS float* CW;
    __device__ __forceinline__ void operator()(const f32x4 (&acc)[2][2][4][2], const Unit& u, int wr, int wc, int fr, int fq) const {
        const int cl = wc * 32 + 8 * fq; const int ch0 = u.pn * 128 + cl;
#pragma unroll
        for (int ai = 0; ai < 2; ++ai) { const int blk = 2 * ai + wr;
            if (fr == 0) {
#pragma unroll
                for (int n = 0; n < 2; ++n) *(PG8_LAS f32x4*)(X + (blk * 2 + 0) * 128 + cl + 4 * n) = acc[ai][0][0][n]; }
            if (fr == 15) {
#pragma unroll
                for (int n = 0; n < 2; ++n) *(PG8_LAS f32x4*)(X + (blk * 2 + 1) * 128 + cl + 4 * n) = acc[ai][0][3][n]; } }
        { const int t = (wr * 4 + wc) * 64 + fq * 16 + fr, k = t >> 7, c = t & 127;
          CW[t] = (k < 3) ? cw[k * FFC + u.pn * 128 + c] : cb[u.pn * 128 + c]; }
        asm volatile("s_waitcnt lgkmcnt(0)" ::: "memory"); __builtin_amdgcn_s_barrier(); asm volatile("" ::: "memory");
        const int lane = fq * 16 + fr; const int srcR = (lane & 48) | ((fr + 15) & 15), srcL = (lane & 48) | ((fr + 1) & 15);
#pragma unroll
        for (int ai = 0; ai < 2; ++ai) { const int blk = 2 * ai + wr; unsigned hb[4][2];
#pragma unroll
            for (int n = 0; n < 2; ++n) {
                const f32x4 w0 = *(const PG8_LAS f32x4*)(CW + cl + 4 * n), w1 = *(const PG8_LAS f32x4*)(CW + 128 + cl + 4 * n), w2 = *(const PG8_LAS f32x4*)(CW + 256 + cl + 4 * n), bb = *(const PG8_LAS f32x4*)(CW + 384 + cl + 4 * n);
                f32x4 ep = (f32x4){0.f, 0.f, 0.f, 0.f}, en = (f32x4){0.f, 0.f, 0.f, 0.f};
                if (blk > 0) ep = *(const PG8_LAS f32x4*)(X + ((blk - 1) * 2 + 1) * 128 + cl + 4 * n);
                if (blk < 3) en = *(const PG8_LAS f32x4*)(X + ((blk + 1) * 2 + 0) * 128 + cl + 4 * n);
                f32x4 R[4], L[4];
#pragma unroll
                for (int m = 0; m < 4; ++m)
#pragma unroll
                    for (int j = 0; j < 4; ++j) { R[m][j] = bperm_(srcR, acc[ai][0][m][n][j]); L[m][j] = bperm_(srcL, acc[ai][0][m][n][j]); }
#pragma unroll
                for (int m = 0; m < 4; ++m) {
                    const f32x4 prev = (fr == 0) ? (m > 0 ? R[m > 0 ? m - 1 : 0] : ep) : R[m];
                    const f32x4 next = (fr == 15) ? (m < 3 ? L[m < 3 ? m + 1 : 3] : en) : L[m];
                    const f32x4 a = w0 * prev + w1 * acc[ai][0][m][n] + w2 * next + bb;
                    f32x4 h;
#pragma unroll
                    for (int j = 0; j < 4; ++j) { const float e = __builtin_amdgcn_exp2f(-1.4426950408889634f * a[j]); h[j] = a[j] * __builtin_amdgcn_rcpf(1.0f + e) * acc[ai][1][m][n][j]; }
                    if (n == 0) { hb[m][0] = cvt_pk_bf16(h[0], h[1]); hb[m][1] = cvt_pk_bf16(h[2], h[3]); }
                    else { u32x4 w; w.x = hb[m][0]; w.y = hb[m][1]; w.z = cvt_pk_bf16(h[0], h[1]); w.w = cvt_pk_bf16(h[2], h[3]);
                        *(u32x4*)(HD + (size_t)(u.pm * BM + ai * HALF + wr * 64 + m * 16 + fr) * FFC + ch0) = w; }
                }
            }
        }
        if (wr == 0 && fr < 2) {
#pragma unroll
            for (int n = 0; n < 2; ++n) { *(f32x4*)(Eg + (size_t)(u.pm * 4 + fr) * FFC + ch0 + 4 * n) = acc[0][0][0][n];
                if (fr == 0) *(f32x4*)(Eu + (size_t)(u.pm * 2 + 0) * FFC + ch0 + 4 * n) = acc[0][1][0][n]; } }
        if (wr == 1 && fr >= 14) {
#pragma unroll
            for (int n = 0; n < 2; ++n) { *(f32x4*)(Eg + (size_t)(u.pm * 4 + 2 + (fr - 14)) * FFC + ch0 + 4 * n) = acc[1][0][3][n];
                if (fr == 15) *(f32x4*)(Eu + (size_t)(u.pm * 2 + 1) * FFC + ch0 + 4 * n) = acc[1][1][3][n]; } }
    }
};

template <class Epi, class Sched, bool ALIGN_EPI = false, bool SP2 = false>
__device__ __forceinline__ void gemm_phase(PG8_LAS unsigned char* lds, const Gemm g, const Sched& S, const Epi& E, int wv) {
    int tid = wv * 64 + lane_id_(); asm volatile("" : "+v"(tid));
    const int wid = __builtin_amdgcn_readfirstlane(tid >> 6), lane = tid & 63, wr = wid >> 2, wc = wid & 3, fr = lane & 15, fq = lane >> 4;
    const int K = g.K, nt = K / BK;
    unsigned voffA[2], voffB[2];
#pragma unroll
    for (int i = 0; i < 2; ++i) { int R, C; stage_rc(tid * 16 + i * 8192, R, C); const int Rb = Epi::PERM ? ((R & ~31) + perm32(R & 31)) : R;
        voffA[i] = (unsigned)(R * g.lda + C) * 2u; voffB[i] = (unsigned)(Rb * g.ldb + C) * 2u; }
    const size_t kstep = (size_t)(BK * 2);
    const size_t hsA = (size_t)HALF * g.lda * 2, hsB = (size_t)HALF * g.ldb * 2;
    const size_t tsA = 2 * hsA, tsB = 2 * hsB, kofs = (size_t)K * 2;
    const unsigned ldsw = (unsigned)wid * 1024u;
    const int aoff = lds_byte(wr * 64 + fr, fq * 8), boff = lds_byte(wc * 32 + fr, fq * 8);
#define PG8_SA(b, h) (((b) * 2 + (h)) * HTB)
#define PG8_SB(b, h) ((4 + (b) * 2 + (h)) * HTB)
#define PG8_STAGE(bufoff, gbase, voff) do { _Pragma("unroll") for (int _i = 0; _i < 2; ++_i) \
        __builtin_amdgcn_global_load_lds((const unsigned*)((const char*)(gbase) + (voff)[_i]), (PG8_LAS unsigned*)(lds + (bufoff) + ldsw + _i * 8192), 16, 0, 0); } while (0)
#define PG8_LDA(dst, b, h) do { _Pragma("unroll") for (int m = 0; m < 4; ++m) _Pragma("unroll") for (int k = 0; k < 2; ++k) dst[m][k] = *(const PG8_LAS bf16x8*)(lds + PG8_SA(b, h) + aoff + m * 2048 + k * 1024); } while (0)
#define PG8_LDB(dst, b, h) do { _Pragma("unroll") for (int n = 0; n < 2; ++n) _Pragma("unroll") for (int k = 0; k < 2; ++k) dst[n][k] = *(const PG8_LAS bf16x8*)(lds + PG8_SB(b, h) + boff + n * 2048 + k * 1024); } while (0)
#define PG8_MMA(ai, bj, At, Bt) do { __builtin_amdgcn_s_setprio(1); _Pragma("unroll") for (int m = 0; m < 4; ++m) _Pragma("unroll") for (int n = 0; n < 2; ++n) _Pragma("unroll") for (int k = 0; k < 2; ++k) \
        acc[ai][bj][m][n] = __builtin_amdgcn_mfma_f32_16x16x32_bf16(Bt[n][k], At[m][k], acc[ai][bj][m][n], 0, 0, 0); __builtin_amdgcn_s_setprio(0); } while (0)
#define PG8_WAIT_V(n) asm volatile("s_waitcnt vmcnt(" #n ")" ::: "memory")
#define PG8_WAIT_L(n) asm volatile("s_waitcnt lgkmcnt(" #n ")" ::: "memory")
#define PG8_BAR __builtin_amdgcn_s_barrier()
#define PG8_SCHED __builtin_amdgcn_sched_barrier(0)
    Unit cur, nxt; int ui = 0;
    if (!S.next(0, cur)) return;
    f32x4 acc[2][2][4][2];
#pragma unroll
    for (int a = 0; a < 2; ++a)
#pragma unroll
        for (int b = 0; b < 2; ++b)
#pragma unroll
            for (int m = 0; m < 4; ++m)
#pragma unroll
                for (int n = 0; n < 2; ++n) acc[a][b][m][n] = (f32x4){0.f, 0.f, 0.f, 0.f};
    bf16x8 At[4][2], B0[2][2], B1[2][2];
    const char* cA = (const char*)g.A + (size_t)cur.pm * tsA + (size_t)cur.ks * kofs; const char* cB = (const char*)g.Bt + (size_t)cur.pn * tsB + (size_t)cur.ks * kofs;
    S.a_ready(cur);
    if constexpr (SP2) {
        PG8_STAGE(PG8_SB(0, 0), cB, voffB); PG8_STAGE(PG8_SB(0, 1), cB + hsB, voffB); PG8_STAGE(PG8_SA(0, 0), cA, voffA); PG8_STAGE(PG8_SA(0, 1), cA + hsA, voffA);
        if (wr == 1) PG8_BAR;
        PG8_WAIT_V(2); PG8_BAR;
        PG8_STAGE(PG8_SB(1, 0), cB + kstep, voffB); PG8_STAGE(PG8_SA(1, 0), cA + kstep, voffA); PG8_STAGE(PG8_SB(1, 1), cB + hsB + kstep, voffB);
        PG8_WAIT_V(6); PG8_BAR;
    } else {
        PG8_STAGE(PG8_SB(0, 0), cB, voffB); PG8_STAGE(PG8_SA(0, 0), cA, voffA); PG8_STAGE(PG8_SB(0, 1), cB + hsB, voffB); PG8_STAGE(PG8_SA(0, 1), cA + hsA, voffA);
        if (wr == 1) PG8_BAR;
        PG8_WAIT_V(4); PG8_BAR;
        PG8_STAGE(PG8_SB(1, 0), cB + kstep, voffB); PG8_STAGE(PG8_SA(1, 0), cA + kstep, voffA); PG8_STAGE(PG8_SB(1, 1), cB + hsB + kstep, voffB);
        PG8_WAIT_V(6); PG8_BAR;
    }
    for (;;) {
        const bool has_next = S.next(ui + 1, nxt);
        const char* nA = has_next ? (const char*)g.A + (size_t)nxt.pm * tsA + (size_t)nxt.ks * kofs : cA; const char* nB = has_next ? (const char*)g.Bt + (size_t)nxt.pn * tsB + (size_t)nxt.ks * kofs : cB;
        const int ntu = cur.nt ? cur.nt : nt;
        for (int t = 0; t < ntu; t += 2) {
            const bool last = (t == ntu - 2);
            const char* a1 = cA + (size_t)(t + 1) * kstep;
            const char* a2 = last ? nA : cA + (size_t)(t + 2) * kstep; const char* b2 = last ? nB : cB + (size_t)(t + 2) * kstep;
            const char* a3 = a2 + kstep; const char* b3 = b2 + kstep;
            if (last && has_next) S.a_ready(nxt);
            if constexpr (SP2) {
            PG8_LDB(B0, 0, 0); PG8_LDB(B1, 0, 1); PG8_SCHED; PG8_LDA(At, 0, 0); PG8_STAGE(PG8_SA(1, 1), a1 + hsA, voffA);
            PG8_WAIT_V(8); PG8_WAIT_L(0); PG8_BAR; PG8_MMA(0, 0, At, B0); PG8_MMA(0, 1, At, B1); PG8_BAR; PG8_SCHED;
            PG8_LDA(At, 0, 1); PG8_STAGE(PG8_SB(0, 0), b2, voffB); PG8_STAGE(PG8_SB(0, 1), b2 + hsB, voffB); PG8_STAGE(PG8_SA(0, 0), a2, voffA);
            PG8_WAIT_V(8); PG8_WAIT_L(0); PG8_BAR; PG8_MMA(1, 0, At, B0); PG8_MMA(1, 1, At, B1); PG8_BAR; PG8_SCHED;
            PG8_LDB(B0, 1, 0); PG8_LDB(B1, 1, 1); PG8_SCHED; PG8_LDA(At, 1, 0); PG8_STAGE(PG8_SA(0, 1), a2 + hsA, voffA);
            PG8_WAIT_V(8); PG8_WAIT_L(0); PG8_BAR; PG8_MMA(0, 0, At, B0); PG8_MMA(0, 1, At, B1); PG8_BAR; PG8_SCHED;
            PG8_LDA(At, 1, 1); PG8_STAGE(PG8_SB(1, 0), b3, voffB); PG8_STAGE(PG8_SB(1, 1), b3 + hsB, voffB); PG8_STAGE(PG8_SA(1, 0), a3, voffA);
            PG8_WAIT_V(8); PG8_WAIT_L(0); PG8_BAR; PG8_MMA(1, 0, At, B0); PG8_MMA(1, 1, At, B1); PG8_BAR; PG8_SCHED;
            } else {
            PG8_LDB(B0, 0, 0); PG8_SCHED; PG8_LDA(At, 0, 0); PG8_STAGE(PG8_SA(1, 1), a1 + hsA, voffA);
            PG8_WAIT_L(8); PG8_BAR; PG8_WAIT_L(0); PG8_MMA(0, 0, At, B0); PG8_BAR; PG8_SCHED;
            PG8_LDB(B1, 0, 1); PG8_STAGE(PG8_SB(0, 0), b2, voffB);
            PG8_BAR; PG8_WAIT_L(0); PG8_MMA(0, 1, At, B1); PG8_BAR;
            PG8_LDA(At, 0, 1); PG8_STAGE(PG8_SA(0, 0), a2, voffA);
            PG8_BAR; PG8_WAIT_L(0); PG8_MMA(1, 0, At, B0); PG8_BAR; PG8_SCHED;
            PG8_STAGE(PG8_SB(0, 1), b2 + hsB, voffB);
            PG8_WAIT_V(6); PG8_BAR; PG8_MMA(1, 1, At, B1); PG8_BAR;
            PG8_LDB(B0, 1, 0); PG8_SCHED; PG8_LDA(At, 1, 0); PG8_STAGE(PG8_SA(0, 1), a2 + hsA, voffA);
            PG8_WAIT_L(8); PG8_BAR; PG8_WAIT_L(0); PG8_MMA(0, 0, At, B0); PG8_BAR; PG8_SCHED;
            PG8_LDB(B1, 1, 1); PG8_STAGE(PG8_SB(1, 0), b3, voffB);
            PG8_BAR; PG8_WAIT_L(0); PG8_MMA(0, 1, At, B1); PG8_BAR;
            PG8_LDA(At, 1, 1); PG8_STAGE(PG8_SA(1, 0), a3, voffA);
            PG8_BAR; PG8_WAIT_L(0); PG8_MMA(1, 0, At, B0); PG8_BAR; PG8_SCHED;
            PG8_STAGE(PG8_SB(1, 1), b3 + hsB, voffB);
            PG8_WAIT_V(6); PG8_BAR; PG8_MMA(1, 1, At, B1); PG8_BAR;
            }
        }
        if constexpr (ALIGN_EPI) { if (wr == 0) PG8_BAR; }
        if constexpr (!Epi::AFTER_DRAIN) { E(acc, cur, wr, wc, fr, fq); S.done(cur); }
        if (!has_next) break;
#pragma unroll
        for (int a = 0; a < 2; ++a)
#pragma unroll
            for (int b = 0; b < 2; ++b)
#pragma unroll
                for (int m = 0; m < 4; ++m)
#pragma unroll
                    for (int n = 0; n < 2; ++n) acc[a][b][m][n] = (f32x4){0.f, 0.f, 0.f, 0.f};
        cur = nxt; cA = nA; cB = nB; ++ui;
        if constexpr (ALIGN_EPI) { if (wr == 1) PG8_BAR; }
    }
    PG8_WAIT_V(0);
    if constexpr (!ALIGN_EPI) { if (wr == 0) PG8_BAR; }
    PG8_BAR;
#undef PG8_SA
#undef PG8_SB
#undef PG8_STAGE
#undef PG8_LDA
#undef PG8_LDB
#undef PG8_MMA
#undef PG8_WAIT_V
#undef PG8_WAIT_L
#undef PG8_BAR
#undef PG8_SCHED
}
}

namespace att {
typedef unsigned short bf16_t;
using bf16x8 = __attribute__((ext_vector_type(8))) short;
using s16x4  = __attribute__((ext_vector_type(4))) short;
using f32x16 = __attribute__((ext_vector_type(16))) float;
using u32x4  = __attribute__((ext_vector_type(4))) unsigned;
constexpr int NW = 8, QBLK = 32, KVBLK = 64;
constexpr float THR = 8.f;
constexpr int SHM_V = 16384, SHM_K = 16384, SHM_KR = 8192;
constexpr int OFF_V = 0, OFF_K = 2 * SHM_V, OFF_WS = OFF_K + 2 * SHM_K, OFF_KR = OFF_WS + 2048, OFF_RPB = OFF_KR + 2 * SHM_KR, OFF_Q2 = OFF_RPB + 2048, LDS_TOTAL = OFF_Q2 + 32768;
#define KSWZ(row, colB) ((row) * 256 + ((colB) ^ (((row) & 7) << 4)))
#define KRSWZ(row, colB) ((row) * 128 + ((colB) ^ ((((row) >> 1) & 7) << 4)))
#define SBAR() __builtin_amdgcn_sched_barrier(0)
__device__ __forceinline__ int crow(int r, int hi) { return (r & 3) + 8 * (r >> 2) + 4 * hi; }
__device__ __forceinline__ unsigned cvtpk(float lo, float hi) { unsigned r; asm volatile("v_cvt_pk_bf16_f32 %0, %1, %2" : "=v"(r) : "v"(lo), "v"(hi)); return r; }
__device__ __forceinline__ unsigned short f2bf(float f) { unsigned u = __builtin_bit_cast(unsigned, f); return (unsigned short)((u + 0x7fffu + ((u >> 16) & 1u)) >> 16); }

template <bool MLA> __device__ __forceinline__ void partialSM(f32x16& p0, f32x16& p1, float& m_reg, float& mn, float& alpha) {
  constexpr float SCALE = MLA ? 0.07216878364870322f : 0.08838834764831845f;
  constexpr float C = SCALE * 1.4426950408889634f;
  float pmax = p0[0];
#pragma unroll
  for (int r = 1; r < 16; ++r) pmax = fmaxf(pmax, p0[r]);
#pragma unroll
  for (int r = 0; r < 16; ++r) pmax = fmaxf(pmax, p1[r]);
  { auto rr = __builtin_amdgcn_permlane32_swap(__float_as_uint(pmax), __float_as_uint(pmax), false, false);
    pmax = fmaxf(__uint_as_float(rr[0]), __uint_as_float(rr[1])); }
  if (__builtin_expect(__all(pmax - m_reg <= THR / SCALE), 1)) { mn = m_reg; alpha = 1.f; }
  else { mn = fmaxf(m_reg, pmax); alpha = __builtin_amdgcn_exp2f((m_reg - mn) * C); m_reg = mn; }
  float mnC = -mn * C;
#pragma unroll
  for (int r = 0; r < 16; ++r) p0[r] = fmaf(p0[r], C, mnC);
#pragma unroll
  for (int r = 0; r < 16; ++r) p1[r] = fmaf(p1[r], C, mnC);
#pragma unroll
  for (int r = 0; r < 16; ++r) p0[r] = __builtin_amdgcn_exp2f(p0[r]);
}
__device__ __forceinline__ void finishSM(f32x16& p0, f32x16& p1, float alpha, float& l_reg, bf16x8& pa0, bf16x8& pa1, bf16x8& pa2, bf16x8& pa3) {
#pragma unroll
  for (int r = 0; r < 16; ++r) p1[r] = __builtin_amdgcn_exp2f(p1[r]);
  float ps = 0;
#pragma unroll
  for (int r = 0; r < 16; ++r) ps += p0[r];
#pragma unroll
  for (int r = 0; r < 16; ++r) ps += p1[r];
  { auto rr = __builtin_amdgcn_permlane32_swap(__float_as_uint(ps), __float_as_uint(ps), false, false);
    ps = __uint_as_float(rr[0]) + __uint_as_float(rr[1]); }
  l_reg = l_reg * alpha + ps;
#define PK4(P, BASE, OUT) do { unsigned a0 = cvtpk(P[BASE + 0], P[BASE + 1]), a1 = cvtpk(P[BASE + 2], P[BASE + 3]);   \
    unsigned b0 = cvtpk(P[BASE + 4], P[BASE + 5]), b1 = cvtpk(P[BASE + 6], P[BASE + 7]);                              \
    auto r0 = __builtin_amdgcn_permlane32_swap(a0, b0, false, false); auto r1 = __builtin_amdgcn_permlane32_swap(a1, b1, false, false); \
    u32x4 w = {r0[0], r1[0], r0[1], r1[1]}; OUT = *reinterpret_cast<bf16x8*>(&w); } while (0)
  PK4(p0, 0, pa0); PK4(p0, 8, pa1); PK4(p1, 0, pa2); PK4(p1, 8, pa3);
#undef PK4
}
template <bool MLA> __device__ __forceinline__ void qkt(f32x16& p0, f32x16& p1, const bf16_t* Ks, const bf16_t* KRs, const bf16x8* qr, const char* q2l, int r32, int hi) {
  p0 = f32x16{}; p1 = f32x16{};
#pragma unroll
  for (int d0 = 0; d0 < 8; ++d0) { int cb = (d0 * 16 + hi * 8) * 2;
    bf16x8 b0 = *reinterpret_cast<const bf16x8*>((const char*)Ks + KSWZ(r32, cb));
    bf16x8 b1 = *reinterpret_cast<const bf16x8*>((const char*)Ks + KSWZ(32 + r32, cb));
    p0 = __builtin_amdgcn_mfma_f32_32x32x16_bf16(b0, qr[d0], p0, 0, 0, 0);
    p1 = __builtin_amdgcn_mfma_f32_32x32x16_bf16(b1, qr[d0], p1, 0, 0, 0); }
  if constexpr (MLA) {
#pragma unroll
    for (int d0 = 0; d0 < 4; ++d0) { int cb = (d0 * 16 + hi * 8) * 2;
      bf16x8 b0 = *reinterpret_cast<const bf16x8*>((const char*)KRs + KRSWZ(r32, cb));
      bf16x8 b1 = *reinterpret_cast<const bf16x8*>((const char*)KRs + KRSWZ(32 + r32, cb));
      const bf16x8 q2 = *reinterpret_cast<const bf16x8*>(q2l + d0 * 1024);
      p0 = __builtin_amdgcn_mfma_f32_32x32x16_bf16(b0, q2, p0, 0, 0, 0);
      p1 = __builtin_amdgcn_mfma_f32_32x32x16_bf16(b1, q2, p1, 0, 0, 0); }
  }
}
__device__ __forceinline__ int v_st(int k, int c) { const int kk = (k & ~0xC) | ((k & 4) << 1) | ((k & 8) >> 1); return ((kk >> 3) * 4 + (c >> 5)) * 512 + ((kk & 7) * 32 + (c & 31)) * 2; }
__device__ __forceinline__ int v_rd_base(int lane) { return ((lane & 3) << 3) | (((lane >> 2) & 3) << 6) | (((lane >> 4) & 1) << 5) | (((lane >> 5) & 1) << 8); }
constexpr int v_rd_off(int d0, int ks, int half) { return d0 * 512 + ks * 4096 + half * 2048; }
template <int OFF> __device__ __forceinline__ s16x4 tr_read(int vb) {
  s16x4 r; asm volatile("ds_read_b64_tr_b16 %0, %1 offset:%2" : "=&v"(r) : "v"(vb), "i"(OFF) : "memory"); return r;
}
template <int D0> __device__ __forceinline__ void pv_one(f32x16& od, int vb, bf16x8 pa0, bf16x8 pa1, bf16x8 pa2, bf16x8 pa3) {
  const s16x4 l0 = tr_read<v_rd_off(D0, 0, 0)>(vb), h0 = tr_read<v_rd_off(D0, 0, 1)>(vb), l1 = tr_read<v_rd_off(D0, 1, 0)>(vb), h1 = tr_read<v_rd_off(D0, 1, 1)>(vb);
  const s16x4 l2 = tr_read<v_rd_off(D0, 2, 0)>(vb), h2 = tr_read<v_rd_off(D0, 2, 1)>(vb), l3 = tr_read<v_rd_off(D0, 3, 0)>(vb), h3 = tr_read<v_rd_off(D0, 3, 1)>(vb);
  asm volatile("s_waitcnt lgkmcnt(0)" ::: "memory"); SBAR();
#define PK(L, H) (bf16x8){L[0], L[1], L[2], L[3], H[0], H[1], H[2], H[3]}
  od = __builtin_amdgcn_mfma_f32_32x32x16_bf16(pa0, PK(l0, h0), od, 0, 0, 0);
  od = __builtin_amdgcn_mfma_f32_32x32x16_bf16(pa1, PK(l1, h1), od, 0, 0, 0);
  od = __builtin_amdgcn_mfma_f32_32x32x16_bf16(pa2, PK(l2, h2), od, 0, 0, 0);
  od = __builtin_amdgcn_mfma_f32_32x32x16_bf16(pa3, PK(l3, h3), od, 0, 0, 0);
#undef PK
}
__device__ __forceinline__ void pv_d0(f32x16* o, int vb, bf16x8 pa0, bf16x8 pa1, bf16x8 pa2, bf16x8 pa3) {
  pv_one<0>(o[0], vb, pa0, pa1, pa2, pa3); pv_one<1>(o[1], vb, pa0, pa1, pa2, pa3); pv_one<2>(o[2], vb, pa0, pa1, pa2, pa3); pv_one<3>(o[3], vb, pa0, pa1, pa2, pa3);
}

struct AttnArgs {
  const bf16_t *Q, *Q2, *K, *V, *KR; bf16_t* O;
  int ldq, ldk, ldv, ldkr, ldo;
  int qrow0;
  int ctxrow0;
  int latrow0;
  int NT;
  int qpos0;
  int wstart;
  const float* sinkp; int has_sink;
  const float* rpb;
};

template <int MODE> __device__ __forceinline__ void apply_mask(f32x16& p0, f32x16& p1, int j, const AttnArgs& a, int qp, int hi, const float* rpbL) {
  constexpr float NEG = -1e30f;
  if constexpr (MODE == 2) {
    if (j >= 4) {
      const int kb = a.wstart + 64 * (j - 4) - qp;
#pragma unroll
      for (int r = 0; r < 16; ++r) { const int d0 = kb + crow(r, hi), d1 = d0 + 32;
        if (d0 < -128 || d0 > 128) p0[r] = NEG; if (d1 < -128 || d1 > 128) p1[r] = NEG; }
    }
  } else if constexpr (MODE == 1) {
    if (j >= 4) {
      int qp_ = qp; asm volatile("" : "+v"(qp_));
      const int krow = (a.wstart >> 6) + (j - 4); const int qrow = qp_ >> 6, qcol = qp_ & 63;
      const int r0 = min(max(qrow - 4, 0), 56), c0 = min(max(qcol - 8, 0), 48);
      const bool rowok = (krow >= r0) && (krow < r0 + 8);
      const float* bp = rpbL + min(max(krow - qrow + 7, 0), 14) * 31 + 15 - qcol + 4 * hi;
      const int lo = c0 - 4 * hi, hi_ = lo + 16;
#pragma unroll
      for (int r = 0; r < 16; ++r) { const int k0 = (r & 3) + 8 * (r >> 2), k1 = k0 + 32;
        const bool ok0 = rowok && (k0 >= lo) && (k0 < hi_), ok1 = rowok && (k1 >= lo) && (k1 < hi_);
        const float b0 = bp[k0], b1 = bp[k1];
        p0[r] = ok0 ? p0[r] + b0 : NEG; p1[r] = ok1 ? p1[r] + b1 : NEG; }
    }
  }
}

template <int MODE, bool MLA>
__device__ __forceinline__ void attn_unit(const AttnArgs& a, char* lds, int wv) {
  constexpr float SCALE = MLA ? 0.07216878364870322f : 0.08838834764831845f;
  constexpr float C = SCALE * 1.4426950408889634f;
  constexpr int SDEPTH = (MLA || MODE != 0) ? 1 : 2;
  int tid = wv * 64 + lane_id_(); asm volatile("" : "+v"(tid));
  const int wid = tid >> 6, lane = tid & 63, r32 = lane & 31, hi = lane >> 5;
  bf16_t* V_lds = (bf16_t*)(lds + OFF_V); bf16_t* K_lds = (bf16_t*)(lds + OFF_K); bf16_t* KR_lds = (bf16_t*)(lds + OFF_KR);
  float* ws = (float*)(lds + OFF_WS) + wid * 64; float* li_l = ws; float* al_l = ws + 32;
  float* rpbL = (float*)(lds + OFF_RPB);
  if constexpr (MODE == 1) { for (int i = tid; i < 465; i += 512) rpbL[i] = a.rpb[i] * (1.0f / SCALE); }
  float m_reg = -1e30f, l_reg = 0; f32x16 o[4] = {}; bf16x8 qr[8];
  const char* q2l = lds + OFF_Q2 + (wid * 4 * 64 + lane) * 16;
  const bf16_t* Qw = a.Q + (long)(a.qrow0 + wid * QBLK + r32) * a.ldq + hi * 8;
#pragma unroll
  for (int d0 = 0; d0 < 8; ++d0) qr[d0] = *reinterpret_cast<const bf16x8*>(Qw + d0 * 16);
  if constexpr (MLA) { const bf16_t* Q2w = a.Q2 + (long)(a.qrow0 + wid * QBLK + r32) * a.ldq + hi * 8;
#pragma unroll
    for (int d0 = 0; d0 < 4; ++d0) *(bf16x8*)(const_cast<char*>(q2l) + d0 * 1024) = *reinterpret_cast<const bf16x8*>(Q2w + d0 * 16); }
  const int qp = a.qpos0 + wid * QBLK + r32;
  const int sr = tid >> 4, sc = (tid & 15) * 8, vst0 = v_st(sr, sc), vst1 = v_st(32 + sr, sc);
  const int krr = tid >> 3, krc = (tid & 7) * 8;
  const int vb0 = (int)(uintptr_t)V_lds + v_rd_base(lane);
  struct { bf16x8 vs0, vs1, ks0, ks1, kr; } sr_[SDEPTH];
#define TROW(j) ((j) < 4 ? a.ctxrow0 + 64 * (j) : a.latrow0 + 64 * ((j) - 4))
#define SLOAD(i, j) do { const long row0_ = TROW(j); \
    sr_[i].vs0 = *reinterpret_cast<const bf16x8*>(&a.V[(row0_ + sr) * a.ldv + sc]); sr_[i].vs1 = *reinterpret_cast<const bf16x8*>(&a.V[(row0_ + 32 + sr) * a.ldv + sc]); \
    sr_[i].ks0 = *reinterpret_cast<const bf16x8*>(&a.K[(row0_ + sr) * a.ldk + sc]); sr_[i].ks1 = *reinterpret_cast<const bf16x8*>(&a.K[(row0_ + 32 + sr) * a.ldk + sc]); \
    if constexpr (MLA) sr_[i].kr = *reinterpret_cast<const bf16x8*>(&a.KR[(row0_ + krr) * a.ldkr + krc]); } while (0)
#define SWRITE(b, i) do { *(bf16x8*)((char*)V_lds + (b) * SHM_V + vst0) = sr_[i].vs0; \
    *(bf16x8*)((char*)V_lds + (b) * SHM_V + vst1) = sr_[i].vs1; int kc = sc * 2; \
    *(bf16x8*)((char*)K_lds + (b) * SHM_K + KSWZ(sr, kc)) = sr_[i].ks0; \
    *(bf16x8*)((char*)K_lds + (b) * SHM_K + KSWZ(32 + sr, kc)) = sr_[i].ks1; \
    if constexpr (MLA) *(bf16x8*)((char*)KR_lds + (b) * SHM_KR + KRSWZ(krr, krc * 2)) = sr_[i].kr; } while (0)
#define SWAIT() do { if constexpr (SDEPTH == 1) asm volatile("s_waitcnt vmcnt(0)" ::: "memory"); else asm volatile("s_waitcnt vmcnt(4)" ::: "memory"); } while (0)
#define RESC(al) do { if (__any((al) < 1.f)) { if (hi == 0) al_l[r32] = (al); asm volatile("s_waitcnt lgkmcnt(0)" ::: "memory"); \
    _Pragma("unroll") for (int d = 0; d < 4; ++d) _Pragma("unroll") for (int r = 0; r < 16; ++r) o[d][r] *= al_l[crow(r, hi)]; } } while (0)
#define KB(b) ((const bf16_t*)((const char*)K_lds + (b) * SHM_K))
#define KRB(b) ((const bf16_t*)((const char*)KR_lds + (b) * SHM_KR))
  f32x16 pA0, pA1, pB0, pB1; float mnA, mnB, alA, alB; bf16x8 pa0, pa1, pa2, pa3; const int NT = a.NT;
  constexpr int SE = 0, SO = SDEPTH - 1;
  const int qw0 = a.qpos0 + __builtin_amdgcn_readfirstlane(wid) * QBLK;
  auto skip = [&](int j) -> bool {
    if constexpr (MODE == 2) { if (j < 4) return false; const int kt = a.wstart + 64 * (j - 4); return (kt > qw0 + 31 + 128) || (kt + 63 < qw0 - 128); }
    else if constexpr (MODE == 1) { if (j < 4) return false; const int krow = (a.wstart >> 6) + (j - 4); const int r0 = min(max((qw0 >> 6) - 4, 0), 56); return !((krow >= r0) && (krow < r0 + 8)); }
    else return false; };
  SLOAD(SE, 0); asm volatile("s_waitcnt vmcnt(0)" ::: "memory"); SWRITE(0, SE); __syncthreads();
  qkt<MLA>(pA0, pA1, KB(0), KRB(0), qr, q2l, r32, hi); partialSM<MLA>(pA0, pA1, m_reg, mnA, alA);
  SLOAD(SO, 1); if constexpr (SDEPTH == 2) { if (2 < NT) SLOAD(SE, 2); }
  SWAIT(); SWRITE(1, SO); __syncthreads();
  bool skA = false;
  for (int j = 1; j + 1 < NT; j += 2) {
    const bool skB = skip(j), skA2 = skip(j + 1);
    SBAR(); if (!skB) qkt<MLA>(pB0, pB1, KB(1), KRB(1), qr, q2l, r32, hi);
    if (!skA) finishSM(pA0, pA1, alA, l_reg, pa0, pa1, pa2, pa3); SBAR();
    SLOAD(SO, j + SDEPTH); SBAR();
    if (!skA) pv_d0(o, vb0, pa0, pa1, pa2, pa3); SBAR();
    if (!skB) { apply_mask<MODE>(pB0, pB1, j, a, qp, hi, rpbL); partialSM<MLA>(pB0, pB1, m_reg, mnB, alB); } else alB = 1.f;
    __syncthreads(); SWAIT(); SWRITE(0, SE);
    RESC(alB); __syncthreads();
    SBAR(); if (!skA2) qkt<MLA>(pA0, pA1, KB(0), KRB(0), qr, q2l, r32, hi);
    if (!skB) finishSM(pB0, pB1, alB, l_reg, pa0, pa1, pa2, pa3); SBAR();
    if (SDEPTH == 1 || j + 3 < NT) SLOAD(SE, j + 1 + SDEPTH); SBAR();
    if (!skB) pv_d0(o, vb0 + (int)SHM_V, pa0, pa1, pa2, pa3); SBAR();
    if (!skA2) { apply_mask<MODE>(pA0, pA1, j + 1, a, qp, hi, rpbL); partialSM<MLA>(pA0, pA1, m_reg, mnA, alA); } else alA = 1.f;
    __syncthreads(); SWAIT(); SWRITE(1, SO);
    RESC(alA); __syncthreads();
    skA = skA2;
  }
  { const bool skB = skip(NT - 1);
    SBAR(); if (!skB) qkt<MLA>(pB0, pB1, KB(1), KRB(1), qr, q2l, r32, hi);
    if (!skA) finishSM(pA0, pA1, alA, l_reg, pa0, pa1, pa2, pa3); SBAR();
    if (!skA) pv_d0(o, vb0, pa0, pa1, pa2, pa3); SBAR();
    if (!skB) { apply_mask<MODE>(pB0, pB1, NT - 1, a, qp, hi, rpbL); partialSM<MLA>(pB0, pB1, m_reg, mnB, alB); } else alB = 1.f;
    __syncthreads(); RESC(alB);
    if (!skB) { finishSM(pB0, pB1, alB, l_reg, pa0, pa1, pa2, pa3); SBAR();
      pv_d0(o, vb0 + (int)SHM_V, pa0, pa1, pa2, pa3); } }
  if (a.has_sink) l_reg += __builtin_amdgcn_exp2f((a.sinkp[0] * (1.0f / SCALE) - m_reg) * C);
  if (hi == 0) li_l[r32] = l_reg;
  __syncthreads();
  { char* stg = lds + wid * 8192;
#pragma unroll
    for (int r = 0; r < 16; ++r) { const int orow = crow(r, hi); const float rl = __builtin_amdgcn_rcpf(li_l[orow]);
#pragma unroll
      for (int d0 = 0; d0 < 4; ++d0) *(bf16_t*)(stg + orow * 256 + (d0 * 32 + r32) * 2) = f2bf(o[d0][r] * rl); }
    asm volatile("s_waitcnt lgkmcnt(0)" ::: "memory");
    bf16_t* Ow = a.O + (long)(a.qrow0 + wid * QBLK) * a.ldo;
#pragma unroll
    for (int i = 0; i < 8; ++i) { const int row = i * 4 + (lane >> 4), ch = lane & 15;
      const u32x4 v = *(const u32x4*)(stg + row * 256 + ch * 16);
      *(u32x4*)(Ow + (long)row * a.ldo + ch * 8) = v; } }
  __syncthreads();
#undef TROW
#undef SLOAD
#undef SWRITE
#undef SWAIT
#undef RESC
#undef KB
#undef KRB
}
#undef SBAR
}

typedef unsigned short bf16;
typedef float f32x4 __attribute__((ext_vector_type(4)));
typedef unsigned v4u __attribute__((ext_vector_type(4)));
typedef unsigned v2u __attribute__((ext_vector_type(2)));
#define LAS __attribute__((address_space(3)))
constexpr int DM = 2048, NB = 4, SEQ = 4096, CTX = 256, NLAT = NB * SEQ, NCTX = NB * CTX, MTOT = NLAT + NCTX;
constexpr int INC = 4160, INP = 4352, FF = 5632, UPN = 1792, UPK = 512;
constexpr float ALPHA = 1.4142135623730951f, EPS = 1e-6f;
constexpr size_t MiB = 1u << 20;
constexpr size_t WS_MOD = 1 * MiB, WS_ROPE = 2 * MiB, WS_EDGE = 3 * MiB, WS_WUP = 14 * MiB, WS_WIN = 18 * MiB, WS_WOUT = 52 * MiB, WS_WGU = 68 * MiB, WS_WDN = 156 * MiB,
                 WS_X = 200 * MiB, WS_H = 336 * MiB, WS_R = 404 * MiB;
constexpr size_t WS_P = WS_R, WS_Y = WS_R, WS_A2 = WS_R + 145 * MiB, WS_U2 = WS_R + 162 * MiB, WS_MIX = WS_R + 222 * MiB, WS_HD = WS_R + 145 * MiB, WS_END = WS_R + 332 * MiB;
constexpr size_t WS_YP = WS_R + 72 * MiB;
constexpr size_t EDGE_EU = (size_t)68 * 4 * FF * 4;
constexpr int LDS_BYTES = 147456, LDS_X_OFF = 131072, LDS_MISC_OFF = 131072 + 4096;
constexpr size_t WS_BAR = 4096, CTL_ZERO_BYTES = 65536;

struct Params { const float* in[25]; float* out; unsigned char* ws; };
typedef const __attribute__((address_space(4))) Params* KP;
enum { I_X = 0, I_C, I_CTX, I_CCTX, I_WADA, I_BADA, I_WIN, I_RPB, I_SINK, I_MQN, I_MKVN, I_WUQ, I_WUKV, I_GQN, I_GKN, I_WOUT, I_LN1G, I_LN1B, I_WG, I_WU, I_CW, I_CB, I_WD, I_LN2G, I_LN2B };

__device__ __forceinline__ unsigned f2bf(float f) { unsigned u = __builtin_bit_cast(unsigned, f); return (u + 0x7fffu + ((u >> 16) & 1u)) >> 16; }
__device__ __forceinline__ unsigned pk2(float lo, float hi) { return f2bf(lo) | (f2bf(hi) << 16); }
__device__ __forceinline__ float bf2f(unsigned short b) { return __builtin_bit_cast(float, (unsigned)b << 16); }
__device__ __forceinline__ float wave_sum(float v, int lane) {
#pragma unroll
    for (int o = 1; o < 64; o <<= 1) v += bperm_(lane ^ o, v);
    return v;
}
__device__ __forceinline__ float row16_sum(float v) {
    asm("s_nop 1\n\tv_add_f32_dpp %0, %0, %0 quad_perm:[1,0,3,2] row_mask:0xf bank_mask:0xf\n\t"
        "s_nop 1\n\tv_add_f32_dpp %0, %0, %0 quad_perm:[2,3,0,1] row_mask:0xf bank_mask:0xf\n\t"
        "s_nop 1\n\tv_add_f32_dpp %0, %0, %0 row_half_mirror row_mask:0xf bank_mask:0xf\n\t"
        "s_nop 1\n\tv_add_f32_dpp %0, %0, %0 row_ror:8 row_mask:0xf bank_mask:0xf" : "+v"(v));
    return v;
}
__device__ __forceinline__ float rl_(float v, int l) { return __builtin_bit_cast(float, __builtin_amdgcn_readlane(__builtin_bit_cast(int, v), l)); }
__device__ __forceinline__ float wave_sum_d(float v) { const float r = row16_sum(v); return (rl_(r, 0) + rl_(r, 16)) + (rl_(r, 32) + rl_(r, 48)); }
__device__ __forceinline__ float half_sum_d(float v, int lane) { const float r = row16_sum(v); const float lo = rl_(r, 0) + rl_(r, 16), hi = rl_(r, 32) + rl_(r, 48); return (lane & 32) ? hi : lo; }
#define LDS_WAIT() asm volatile("s_waitcnt lgkmcnt(0)" ::: "memory")


#define XB_TMO      128
#define XB_XCNT(j)  (256  + 64 * (j))
#define XB_XSUB(j)  (1280 + 64 * (j))
#define XB_XGEN(j)  (2304 + 64 * (j))
#define XB_TOP      3328
#define XB_TOPGEN   3392
#define XCD_BAR_WORDS 3456
#define XB_SPIN_CAP (1u << 22)
__device__ __forceinline__ unsigned xb_ld(unsigned* p)              { return __hip_atomic_load(p, __ATOMIC_RELAXED, __HIP_MEMORY_SCOPE_AGENT); }
__device__ __forceinline__ unsigned xb_add(unsigned* p, unsigned v) { return __hip_atomic_fetch_add(p, v, __ATOMIC_RELAXED, __HIP_MEMORY_SCOPE_AGENT); }
__device__ __forceinline__ unsigned xb_xcc_id() { return (unsigned)__builtin_amdgcn_s_getreg((3 << 11) | 20) & 0xFu; }
#define XB_SPIN(cond, bar) do { unsigned _sp = 0; while (cond) { __builtin_amdgcn_s_sleep(1); \
    if ((++_sp & 255u) == 0u) { if (xb_ld(&(bar)[XB_TMO])) break; if (_sp > XB_SPIN_CAP) { atomicAdd(&(bar)[XB_TMO], 1u); break; } } } } while (0)
struct XcdBarrier { unsigned* bar; unsigned x; volatile LAS unsigned* st; };
__device__ __forceinline__ XcdBarrier xcd_barrier_post(unsigned* bar, volatile LAS unsigned* st) {
    XcdBarrier b; b.bar = bar; b.x = xb_xcc_id(); b.st = st;
    if (threadIdx.x == 0) (void)xb_add(&bar[XB_XCNT(b.x)], 1u);
    return b;
}
__device__ __forceinline__ void xcd_barrier_complete(unsigned* bar, unsigned x, unsigned& nloc, unsigned& nx) {
    const unsigned G = gridDim.x * gridDim.y * gridDim.z;
    unsigned sum, cnt, mine, sp = 0u;
    for (;;) {
        sum = 0u; cnt = 0u; mine = 0u;
#pragma unroll
        for (unsigned j = 0; j < 16; ++j) { const unsigned c = xb_ld(&bar[XB_XCNT(j)]); sum += c; cnt += (c > 0u) ? 1u : 0u; mine = (j == x) ? c : mine; }
        if (sum == G) break;
        __builtin_amdgcn_s_sleep(1);
        if ((++sp & 255u) == 0u) { if (xb_ld(&bar[XB_TMO])) break; if (sp > XB_SPIN_CAP) { atomicAdd(&bar[XB_TMO], 1u); break; } }
    }
    nloc = mine > 0u ? mine : 1u; nx = cnt > 0u ? cnt : 1u;
}
__device__ __forceinline__ void xcd_barrier(const XcdBarrier& b, int wv) {
    asm volatile("s_waitcnt vmcnt(0)" ::: "memory");
    __syncthreads();
    if (wv == 0 && lane_id_() == 0) {
        unsigned* bar = b.bar; asm volatile("" : "+s"(bar)); unsigned bx_ = b.x; asm volatile("" : "+s"(bx_));
        __builtin_amdgcn_s_waitcnt(0);
        unsigned nloc = b.st[0], nx = b.st[1];
        if (nloc == 0u) { xcd_barrier_complete(bar, bx_, nloc, nx); b.st[0] = nloc; b.st[1] = nx; }
        const unsigned old = xb_add(&bar[XB_XSUB(bx_)], 1u);
        const unsigned gen = old / nloc;
        if (old + 1u == (gen + 1u) * nloc) {
            __builtin_amdgcn_fence(__ATOMIC_RELEASE, "agent");
            asm volatile("s_waitcnt vmcnt(0)" ::: "memory");
            const unsigned og = xb_add(&bar[XB_TOP], 1u);
            const unsigned tg = og / nx;
            if (og + 1u == (tg + 1u) * nx) xb_add(&bar[XB_TOPGEN], 1u);
            else XB_SPIN(xb_ld(&bar[XB_TOPGEN]) == tg, bar);
            __builtin_amdgcn_fence(__ATOMIC_ACQUIRE, "agent");
            xb_add(&bar[XB_XGEN(bx_)], 1u);
            asm volatile("s_waitcnt vmcnt(0)" ::: "memory");
        } else {
            XB_SPIN(xb_ld(&bar[XB_XGEN(bx_)]) == gen, bar);
            __builtin_amdgcn_fence(__ATOMIC_ACQUIRE, "agent");
            asm volatile("s_waitcnt vmcnt(0)" ::: "memory");
        }
    }
    __syncthreads();
}

__device__ __forceinline__ void tr_item(const float* W, int N, bf16* WT, int ldk, int koff, int drow0, int k0, int n0, LAS float* scr, int lane) {
#pragma unroll 8
    for (int i = 0; i < 32; ++i) { const int kk = 2 * i + (lane >> 5); scr[kk * 33 + (lane & 31)] = W[(size_t)(k0 + kk) * N + n0 + (lane & 31)]; }
    LDS_WAIT(); asm volatile("" ::: "memory");
    const int c = lane & 7;
#pragma unroll
    for (int j = 0; j < 4; ++j) { const int n = (lane >> 3) + 8 * j; const LAS float* s = scr + (8 * c) * 33 + n;
        v4u o; o.x = pk2(s[0 * 33], s[1 * 33]); o.y = pk2(s[2 * 33], s[3 * 33]); o.z = pk2(s[4 * 33], s[5 * 33]); o.w = pk2(s[6 * 33], s[7 * 33]);
        *(v4u*)(WT + (size_t)(drow0 + n) * ldk + koff + k0 + 8 * c) = o; }
    LDS_WAIT(); asm volatile("" ::: "memory");
}
__device__ __forceinline__ void sincos_rr(float ang, float& s, float& c) {
    const float k = rintf(ang * 0.15915494309189535f);
    float r = fmaf(-k, 6.2831855f, ang); r = fmaf(-k, -1.7484555e-7f, r);
    s = __sinf(r); c = __cosf(r);
}
__device__ __forceinline__ void p0_phase(KP p, unsigned char* lds, int wv) {
    asm volatile("" : "+s"(p));
    int tid = wv * 64 + lane_id_(); asm volatile("" : "+v"(tid)); const int lane = tid & 63, wave = tid >> 6;
    unsigned char* ws = p->ws;
    { const int gt = blockIdx.x * 512 + tid; float2* T128 = (float2*)(ws + WS_ROPE); float2* T64 = T128 + 64 * 32;
      if (gt < 64 * 32) { const int pos = gt >> 5, i = gt & 31; const float f = exp2f(-(float)i * (13.287712379549449f / 32.0f)); float s, c; sincos_rr((float)pos * f, s, c); T128[gt] = make_float2(c, s); }
      else if (gt < 64 * 32 + 64 * 16) { const int g2 = gt - 64 * 32; const int pos = g2 >> 4, i = g2 & 15; const float f = exp2f(-(float)i * (13.287712379549449f / 16.0f)); float s, c; sincos_rr((float)pos * f, s, c); T64[g2] = make_float2(c, s); } }
    { const int gt = blockIdx.x * 512 + tid, GT = gridDim.x * 512;
      for (int i = gt; i < 2 * 61440; i += GT) { const int l = i / 61440; int r = i % 61440; bf16* W = (bf16*)(ws + WS_WUP) + (size_t)l * UPN * UPK;
        int row, col; if (r < 768 * 16) { row = r >> 4; col = 384 + (r & 15) * 8; } else { r -= 768 * 16; row = 768 + r / 48; col = (r % 48) * 8; }
        *(v4u*)(W + (size_t)row * UPK + col) = (v4u){0u, 0u, 0u, 0u}; } }
    { float* sv = (float*)lds; float* red = sv + 5 * 2048;
      for (int i = tid; i < 5 * 2048; i += 512) { const int v = i >> 11, k = i & 2047; const float x = v < 4 ? p->in[I_C][v * 2048 + k] : p->in[I_CCTX][k]; sv[i] = x / (1.0f + __expf(-x)); }
      __syncthreads();
      float* mod = (float*)(ws + WS_MOD);
      for (int item = blockIdx.x; item < 768; item += gridDim.x) {
        const int l = item / 384, n0 = (item % 384) * 32, col = tid & 31, kq = tid >> 5;
        const float* W = p->in[I_WADA] + (size_t)l * 2048 * 12288 + n0 + col;
        float acc[5] = {0.f, 0.f, 0.f, 0.f, 0.f};
        for (int k = kq * 128; k < kq * 128 + 128; k += 8) { float w[8];
#pragma unroll
          for (int u = 0; u < 8; ++u) w[u] = W[(size_t)(k + u) * 12288];
#pragma unroll
          for (int u = 0; u < 8; ++u)
#pragma unroll
            for (int v = 0; v < 5; ++v) acc[v] = fmaf(sv[v * 2048 + k + u], w[u], acc[v]); }
#pragma unroll
        for (int v = 0; v < 5; ++v) red[(kq * 5 + v) * 32 + col] = acc[v];
        __syncthreads();
        if (tid < 160) { const int v = tid >> 5, cc = tid & 31; float sacc = 0.f;
#pragma unroll
          for (int q = 0; q < 16; ++q) sacc += red[(q * 5 + v) * 32 + cc];
          mod[(size_t)(l * 5 + v) * 12288 + n0 + cc] = sacc + p->in[I_BADA][l * 12288 + n0 + cc]; }
        __syncthreads();
      } }
    { LAS float* scr = (LAS float*)((LAS unsigned char*)lds + 65536 + wave * 8704);
      const int gw = blockIdx.x * 8 + wave, NGW = gridDim.x * 8;
      constexpr int I_IN = 32 * 130, I_OUT = 32 * 64, I_G = 32 * 176, I_U = 32 * 176, I_DN = 88 * 64, I_UQ = 6 * 24, I_UKV = 2 * 32, I_L = I_IN + I_OUT + I_G + I_U + I_DN + I_UQ + I_UKV;
      for (int it = gw; it < 2 * I_L; it += NGW) {
        const int l = it / I_L; int r = it % I_L;
        if (r < I_IN) { const int kb = r / 130, nb = r % 130; tr_item(p->in[I_WIN] + (size_t)l * DM * INC, INC, (bf16*)(ws + WS_WIN) + (size_t)l * INP * DM, DM, 0, nb * 32, kb * 64, nb * 32, scr, lane); continue; } r -= I_IN;
        if (r < I_OUT) { const int kb = r / 64, nb = r % 64; tr_item(p->in[I_WOUT] + (size_t)l * DM * DM, DM, (bf16*)(ws + WS_WOUT) + (size_t)l * DM * DM, DM, 0, nb * 32, kb * 64, nb * 32, scr, lane); continue; } r -= I_OUT;
        if (r < I_G) { const int kb = r / 176, nb = r % 176, n0 = nb * 32; tr_item(p->in[I_WG] + (size_t)l * DM * FF, FF, (bf16*)(ws + WS_WGU) + (size_t)l * 2 * FF * DM, DM, 0, (n0 >> 7) * 256 + (n0 & 127), kb * 64, n0, scr, lane); continue; } r -= I_G;
        if (r < I_U) { const int kb = r / 176, nb = r % 176, n0 = nb * 32; tr_item(p->in[I_WU] + (size_t)l * DM * FF, FF, (bf16*)(ws + WS_WGU) + (size_t)l * 2 * FF * DM, DM, 0, (n0 >> 7) * 256 + 128 + (n0 & 127), kb * 64, n0, scr, lane); continue; } r -= I_U;
        if (r < I_DN) { const int kb = r / 64, nb = r % 64; tr_item(p->in[I_WD] + (size_t)l * FF * DM, DM, (bf16*)(ws + WS_WDN) + (size_t)l * DM * FF, FF, 0, nb * 32, kb * 64, nb * 32, scr, lane); continue; } r -= I_DN;
        if (r < I_UQ) { const int kb = r / 24, nb = r % 24; tr_item(p->in[I_WUQ] + (size_t)l * 384 * 768, 768, (bf16*)(ws + WS_WUP) + (size_t)l * UPN * UPK, UPK, 0, nb * 32, kb * 64, nb * 32, scr, lane); continue; } r -= I_UQ;
        { const int kb = r / 32, nb = r % 32; tr_item(p->in[I_WUKV] + (size_t)l * 128 * 1024, 1024, (bf16*)(ws + WS_WUP) + (size_t)l * UPN * UPK, UPK, 384, 768 + nb * 32, kb * 64, nb * 32, scr, lane); }
      } }
}

typedef _Float16 h16x4 __attribute__((ext_vector_type(4)));
__device__ __forceinline__ void ln_mod_store(const f32x4 (&v)[8], const float* shift, const float* scale, bf16* hrow, int lane) {
    float s = 0.f;
#pragma unroll
    for (int j = 0; j < 8; ++j) s += (v[j].x + v[j].y) + (v[j].z + v[j].w);
    const float mean = wave_sum(s, lane) * (1.f / DM); float s2 = 0.f;
#pragma unroll
    for (int j = 0; j < 8; ++j) { const f32x4 d = v[j] - mean; s2 += (d.x * d.x + d.y * d.y) + (d.z * d.z + d.w * d.w); }
    const float rstd = 1.0f / sqrtf(wave_sum(s2, lane) * (1.f / DM) + EPS);
#pragma unroll
    for (int j = 0; j < 8; ++j) { const int c = 4 * (64 * j + lane); const f32x4 sh = *(const f32x4*)(shift + c), sc = *(const f32x4*)(scale + c);
        const f32x4 y = (v[j] - mean) * rstd * (sc + 1.0f) + sh;
        v2u w; w.x = pk2(y.x, y.y); w.y = pk2(y.z, y.w); *(v2u*)(hrow + c) = w; }
}
__device__ __forceinline__ void modulate0_phase(KP p, int wv, unsigned char* lds) {
    asm volatile("" : "+s"(p));
    int tid_ = wv * 64 + lane_id_(); asm volatile("" : "+v"(tid_)); const int lane = tid_ & 63, wave = wv; const int gw = blockIdx.x * 8 + wave, NGW = gridDim.x * 8;
    const float* mod = (const float*)(p->ws + WS_MOD); bf16* H = (bf16*)(p->ws + WS_H);
    LAS float* Lw = (LAS float*)(LAS unsigned char*)lds;
    for (int i = tid_; i < 5 * 1024; i += 512) { const int v = i >> 10, c = 4 * (i & 1023); *(LAS f32x4*)(Lw + 4096 * v + c) = *(const f32x4*)(mod + (size_t)v * 12288 + c); }
    __syncthreads();
    const LAS float* L = Lw;
    for (int m0 = gw; m0 < MTOT; m0 += 2 * NGW) {
        f32x4 x[2][8];
#pragma unroll
        for (int r = 0; r < 2; ++r) { const int m = m0 + r * NGW; if (m >= MTOT) break;
            const float* xr = m < NLAT ? p->in[I_X] + (size_t)m * DM : p->in[I_CTX] + (size_t)(m - NLAT) * DM;
#pragma unroll
            for (int j = 0; j < 8; ++j) { const int c = 4 * (64 * j + lane); x[r][j] = *(const f32x4*)(xr + c);
                *(h16x4*)((_Float16*)(p->ws + WS_X) + (size_t)m * DM + c) = __builtin_convertvector(x[r][j], h16x4); } }
#pragma unroll
        for (int r = 0; r < 2; ++r) { const int m = m0 + r * NGW; if (m >= MTOT) break; const int v = m < NLAT ? (m >> 12) : 4;
            float s = 0.f;
#pragma unroll
            for (int j = 0; j < 8; ++j) s += (x[r][j].x + x[r][j].y) + (x[r][j].z + x[r][j].w);
            const float mean = wave_sum(s, lane) * (1.f / DM); float s2 = 0.f;
#pragma unroll
            for (int j = 0; j < 8; ++j) { const f32x4 d = x[r][j] - mean; s2 += (d.x * d.x + d.y * d.y) + (d.z * d.z + d.w * d.w); }
            const float rstd = 1.0f / sqrtf(wave_sum(s2, lane) * (1.f / DM) + EPS);
#pragma unroll
            for (int j = 0; j < 8; ++j) { const int c = 4 * (64 * j + lane); const f32x4 sh = *(const LAS f32x4*)(L + 4096 * v + c), sc = *(const LAS f32x4*)(L + 4096 * v + 2048 + c);
                const f32x4 y = (x[r][j] - mean) * rstd * (sc + 1.0f) + sh;
                v2u w; w.x = pk2(y.x, y.y); w.y = pk2(y.z, y.w); *(v2u*)(H + (size_t)m * DM + c) = w; } }
    }
    __syncthreads();
}
__device__ __forceinline__ f32x4 bf4(v2u w) { return (f32x4){__builtin_bit_cast(float, w.x << 16), __builtin_bit_cast(float, w.x & 0xffff0000u), __builtin_bit_cast(float, w.y << 16), __builtin_bit_cast(float, w.y & 0xffff0000u)}; }
constexpr int RP_LG = 0, RP_LB = 2048, RP_V0 = 4096, RP_VS = 6144;
template <int NR, bool PART>
__device__ __forceinline__ void rowpass_rows(KP p, int l, int which, int mbeg, int mend, int wv, unsigned char* lds) {
    int tid_ = wv * 64 + lane_id_(); asm volatile("" : "+v"(tid_)); const int lane = tid_ & 63, wave = wv;     const int gw = blockIdx.x * 8 + wave, NGW = gridDim.x * 8;
    const float* mod = (const float*)(p->ws + WS_MOD); bf16* H = (bf16*)(p->ws + WS_H); _Float16* X = (_Float16*)(p->ws + WS_X); const bf16* Y = (const bf16*)(p->ws + WS_Y);
    const float* lg = p->in[which == 1 ? I_LN1G : I_LN2G] + l * DM; const float* lb = p->in[which == 1 ? I_LN1B : I_LN2B] + l * DM;
    const bool last = (l == 1 && which == 2);
    const LAS float* L = (const LAS float*)(LAS unsigned char*)lds;
    {
        LAS float* Lw = (LAS float*)(LAS unsigned char*)lds;
        { const int c = 4 * tid_; const f32x4 a = *(const f32x4*)(lg + c), b = *(const f32x4*)(lb + c); *(LAS f32x4*)(Lw + RP_LG + c) = a; *(LAS f32x4*)(Lw + RP_LB + c) = b; }
        constexpr int NV = PART ? 1 : 4;
        f32x4 gt[NV], s1[NV], s2[NV]; const int c = 4 * tid_;
#pragma unroll
        for (int v = 0; v < NV; ++v) { const int vr = PART ? 4 : v;
            gt[v] = *(const f32x4*)(mod + (size_t)(l * 5 + vr) * 12288 + (which == 1 ? 2 : 5) * DM + c);
            const float* sh = which == 1 ? mod + (size_t)(l * 5 + vr) * 12288 + 3 * DM : mod + (size_t)((l == 1 ? 1 : l + 1) * 5 + vr) * 12288 + 0 * DM;
            s1[v] = *(const f32x4*)(sh + c); s2[v] = *(const f32x4*)(sh + DM + c); }
#pragma unroll
        for (int v = 0; v < NV; ++v) { *(LAS f32x4*)(Lw + RP_V0 + RP_VS * v + c) = gt[v]; *(LAS f32x4*)(Lw + RP_V0 + RP_VS * v + 2048 + c) = s1[v]; *(LAS f32x4*)(Lw + RP_V0 + RP_VS * v + 4096 + c) = s2[v]; }
        __syncthreads();
    }
    for (int m0 = mbeg + gw; m0 < mend; m0 += NR * NGW) {
        f32x4 z[NR][8];
#pragma unroll
        for (int r = 0; r < NR; ++r) { const int m = m0 + r * NGW; if (m >= mend) break; const int v = PART ? 0 : (m >> 12);
            const _Float16* xh = X + (size_t)m * DM;
            const bf16* yr = PART ? (const bf16*)(p->ws + WS_YP) + (size_t)(m - NLAT) * DM : Y + (size_t)m * DM;
            if constexpr (PART) {
                v2u yw[4][8]; h16x4 xw[8];
#pragma unroll
                for (int j = 0; j < 8; ++j) { const int c = 4 * (64 * j + lane);
#pragma unroll
                    for (int ks = 0; ks < 4; ++ks) yw[ks][j] = *(const v2u*)(yr + (size_t)ks * 1024 * DM + c);
                    xw[j] = *(const h16x4*)(xh + c); }
#pragma unroll
                for (int j = 0; j < 8; ++j) { const int c = 4 * (64 * j + lane); const f32x4 yv = (bf4(yw[0][j]) + bf4(yw[1][j])) + (bf4(yw[2][j]) + bf4(yw[3][j]));
                    z[r][j] = __builtin_convertvector(xw[j], f32x4) * ALPHA + *(const LAS f32x4*)(L + RP_V0 + c) * yv; }
            } else {
#pragma unroll
                for (int j = 0; j < 8; ++j) { const int c = 4 * (64 * j + lane); const f32x4 yv = bf4(*(const v2u*)(yr + c));
                    const f32x4 xv = __builtin_convertvector(*(const h16x4*)(xh + c), f32x4);
                    const f32x4 gv = *(const LAS f32x4*)(L + RP_V0 + RP_VS * v + c);
                    z[r][j] = xv * ALPHA + gv * yv; } } }
#pragma unroll
        for (int r = 0; r < NR; ++r) { const int m = m0 + r * NGW; if (m >= mend) break; const int v = PART ? 0 : (m >> 12);
            float s = 0.f;
#pragma unroll
            for (int j = 0; j < 8; ++j) s += (z[r][j].x + z[r][j].y) + (z[r][j].z + z[r][j].w);
            const float mean = wave_sum(s, lane) * (1.f / DM); float s2 = 0.f;
#pragma unroll
            for (int j = 0; j < 8; ++j) { const f32x4 d = z[r][j] - mean; s2 += (d.x * d.x + d.y * d.y) + (d.z * d.z + d.w * d.w); }
            const float rstd = 1.0f / sqrtf(wave_sum(s2, lane) * (1.f / DM) + EPS);
            float* xo = p->out + (size_t)m * DM; _Float16* xoh = X + (size_t)m * DM;
            if constexpr (PART) asm volatile("" ::: "memory");
#pragma unroll
            for (int j = 0; j < 8; ++j) { const int c = 4 * (64 * j + lane);
                const f32x4 gg = *(const LAS f32x4*)(L + RP_LG + c), bb = *(const LAS f32x4*)(L + RP_LB + c);
                z[r][j] = (z[r][j] - mean) * rstd * gg + bb;
                if (last) *(f32x4*)(xo + c) = z[r][j]; else *(h16x4*)(xoh + c) = __builtin_convertvector(z[r][j], h16x4); }
            if (!last) {
                {
                    float t = 0.f;
#pragma unroll
                    for (int j = 0; j < 8; ++j) t += (z[r][j].x + z[r][j].y) + (z[r][j].z + z[r][j].w);
                    const float mean2 = wave_sum(t, lane) * (1.f / DM); float t2 = 0.f;
#pragma unroll
                    for (int j = 0; j < 8; ++j) { const f32x4 d = z[r][j] - mean2; t2 += (d.x * d.x + d.y * d.y) + (d.z * d.z + d.w * d.w); }
                    const float rstd2 = 1.0f / sqrtf(wave_sum(t2, lane) * (1.f / DM) + EPS);
                    if constexpr (PART) asm volatile("" ::: "memory");
#pragma unroll
                    for (int j = 0; j < 8; ++j) { const int c = 4 * (64 * j + lane); const f32x4 shv = *(const LAS f32x4*)(L + RP_V0 + RP_VS * v + 2048 + c), scv = *(const LAS f32x4*)(L + RP_V0 + RP_VS * v + 4096 + c);
                        const f32x4 y = (z[r][j] - mean2) * rstd2 * (scv + 1.0f) + shv;
                        v2u w; w.x = pk2(y.x, y.y); w.y = pk2(y.z, y.w); *(v2u*)(H + (size_t)m * DM + c) = w; }
                } } }
    }
    __syncthreads();
}
__device__ __forceinline__ void rowpass_phase(KP p, int l, int which, int M, int wv, unsigned char* lds) {
    asm volatile("" : "+s"(p));
    rowpass_rows<2, false>(p, l, which, 0, NLAT, wv, lds);
    if (M > NLAT) { asm volatile("" : "+s"(p)); rowpass_rows<1, true>(p, l, which, NLAT, M, wv, lds); }
}
__device__ __forceinline__ float half_sum(float v, int lane) {
#pragma unroll
    for (int o = 1; o < 32; o <<= 1) v += bperm_(lane ^ o, v);
    return v;
}
__device__ __forceinline__ void prep_phase(KP p, int l, int wv) {
    asm volatile("" : "+s"(p));
    int tid_ = wv * 64 + lane_id_(); asm volatile("" : "+v"(tid_)); const int lane = tid_ & 63, wave = wv; const int gw = blockIdx.x * 8 + wave, NGW = gridDim.x * 8;
    bf16* P = (bf16*)(p->ws + WS_P); bf16* A2 = (bf16*)(p->ws + WS_A2);
    const float2* T128 = (const float2*)(p->ws + WS_ROPE); const float2* T64 = T128 + 64 * 32;
    const float* gq = p->in[I_GQN] + l * 128; const float* gk = p->in[I_GKN] + l * 128; const float* mq = p->in[I_MQN] + l * 384; const float* mkv = p->in[I_MKVN] + l * 128;
    const int hs = lane >> 5, li = lane & 31, hf = li >> 4, i0 = 2 * (li & 15), e1 = 64 * hf + i0, e2 = e1 + 32;
    const float gq0 = gq[e1], gq1 = gq[e1 + 1], gq2 = gq[e2], gq3 = gq[e2 + 1], gk0 = gk[e1], gk1 = gk[e1 + 1], gk2 = gk[e2], gk3 = gk[e2 + 1];
    float mqr[6];
#pragma unroll
    for (int k = 0; k < 3; ++k) { mqr[2 * k] = mq[2 * lane + 128 * k]; mqr[2 * k + 1] = mq[2 * lane + 128 * k + 1]; }
    const float mkv0 = mkv[2 * lane], mkv1 = mkv[2 * lane + 1];
    for (int m = gw; m < MTOT; m += NGW) {
        bf16* pr = P + (size_t)m * INP; const bool isctx = m >= NLAT; const int t = m & 4095, grow = t >> 6, gcol = t & 63;
        unsigned wb1[3], wb2[3], wd1[3], wd2[3], wc[3], wk; unsigned short k1 = 0, k2 = 0;
        const int hf2 = (lane >> 4) & 1, i16 = lane & 15; bf16* kp = pr + 3072 + hf2 * 32 + i16;
#pragma unroll
        for (int hh = 0; hh < 3; ++hh) { const int h = 2 * hh + hs; const bf16* hb = pr + (h < 4 ? 1536 + h * 128 : 2048 + (h - 4) * 128); const bf16* hd = pr + (h < 4 ? 3136 + h * 128 : 3648 + (h - 4) * 128);
            wb1[hh] = *(const unsigned*)(hb + e1); wb2[hh] = *(const unsigned*)(hb + e2); wd1[hh] = *(const unsigned*)(hd + e1); wd2[hh] = *(const unsigned*)(hd + e2); }
#pragma unroll
        for (int k = 0; k < 3; ++k) wc[k] = *(const unsigned*)(pr + 2560 + 2 * lane + 128 * k);
        wk = *(const unsigned*)(pr + 2944 + 2 * lane);
        if (lane < 32) { k1 = kp[0]; k2 = kp[16]; }
        float c0 = 1.f, s0 = 0.f, c1 = 1.f, s1 = 0.f, ck = 1.f, sk = 0.f;
        if (!isctx) { const float2 a = T128[(hf ? gcol : grow) * 32 + i0], b = T128[(hf ? gcol : grow) * 32 + i0 + 1]; c0 = a.x; s0 = a.y; c1 = b.x; s1 = b.y;
            const float2 cs = T64[(hf2 ? gcol : grow) * 16 + i16]; ck = cs.x; sk = cs.y; }
        if (!isctx) {
#pragma unroll
            for (int hh = 0; hh < 3; ++hh) { const int h = 2 * hh + hs; bf16* hp = pr + (h < 4 ? 1536 + h * 128 : 2048 + (h - 4) * 128); const unsigned w1 = wb1[hh], w2 = wb2[hh];
                const float x1a = __builtin_bit_cast(float, w1 << 16), x1b = __builtin_bit_cast(float, w1 & 0xffff0000u), x2a = __builtin_bit_cast(float, w2 << 16), x2b = __builtin_bit_cast(float, w2 & 0xffff0000u);
                *(unsigned*)(hp + e1) = pk2(x1a * c0 - x2a * s0, x1b * c1 - x2b * s1); *(unsigned*)(hp + e2) = pk2(x2a * c0 + x1a * s0, x2b * c1 + x1b * s1); }
        }
#pragma unroll
        for (int hh = 0; hh < 3; ++hh) { const int h = 2 * hh + hs; bf16* hp = pr + (h < 4 ? 3136 + h * 128 : 3648 + (h - 4) * 128); const unsigned w1 = wd1[hh], w2 = wd2[hh];
            float x1a = __builtin_bit_cast(float, w1 << 16), x1b = __builtin_bit_cast(float, w1 & 0xffff0000u), x2a = __builtin_bit_cast(float, w2 << 16), x2b = __builtin_bit_cast(float, w2 & 0xffff0000u);
            const float ss = half_sum_d((x1a * x1a + x1b * x1b) + (x2a * x2a + x2b * x2b), lane); const float rstd = 1.0f / sqrtf(ss * (1.f / 128.f) + EPS);
            x1a *= rstd * (h < 4 ? gq0 : gk0); x1b *= rstd * (h < 4 ? gq1 : gk1); x2a *= rstd * (h < 4 ? gq2 : gk2); x2b *= rstd * (h < 4 ? gq3 : gk3);
            *(unsigned*)(hp + e1) = pk2(x1a * c0 - x2a * s0, x1b * c1 - x2b * s1); *(unsigned*)(hp + e2) = pk2(x2a * c0 + x1a * s0, x2b * c1 + x1b * s1); }
        { float xv[6]; float ss = 0.f;
#pragma unroll
          for (int k = 0; k < 3; ++k) { xv[2 * k] = __builtin_bit_cast(float, wc[k] << 16); xv[2 * k + 1] = __builtin_bit_cast(float, wc[k] & 0xffff0000u); ss += xv[2 * k] * xv[2 * k] + xv[2 * k + 1] * xv[2 * k + 1]; }
          const float rstd = 1.0f / sqrtf(wave_sum_d(ss) * (1.f / 384.f) + EPS);
#pragma unroll
          for (int k = 0; k < 3; ++k) { const int e = 2 * lane + 128 * k; *(unsigned*)(A2 + (size_t)m * UPK + e) = pk2(xv[2 * k] * rstd * mqr[2 * k], xv[2 * k + 1] * rstd * mqr[2 * k + 1]); } }
        { const float x1 = __builtin_bit_cast(float, wk << 16), x2 = __builtin_bit_cast(float, wk & 0xffff0000u);
          const float rstd = 1.0f / sqrtf(wave_sum_d(x1 * x1 + x2 * x2) * (1.f / 128.f) + EPS);
          *(unsigned*)(A2 + (size_t)m * UPK + 384 + 2 * lane) = pk2(x1 * rstd * mkv0, x2 * rstd * mkv1); }
        if (!isctx && lane < 32) { const float x1 = bf2f(k1), x2 = bf2f(k2); kp[0] = (bf16)f2bf(x1 * ck - x2 * sk); kp[16] = (bf16)f2bf(x2 * ck + x1 * sk); }
    }
}
__device__ __forceinline__ void qpe_phase(KP p, int wv) {
    int tid_ = wv * 64 + lane_id_(); asm volatile("" : "+v"(tid_)); const int lane = tid_ & 63, wave = tid_ >> 6; const int gw = blockIdx.x * 8 + wave, NGW = gridDim.x * 8;
    bf16* U2 = (bf16*)(p->ws + WS_U2); const float2* T64 = (const float2*)(p->ws + WS_ROPE) + 64 * 32;
    const int hsel = lane >> 5, l32 = lane & 31, hf = l32 >> 4, i16 = l32 & 15;
    for (int m = gw; m < NLAT; m += NGW) { const int t = m & 4095, grow = t >> 6, gcol = t & 63; const float2 cs = T64[(hf ? gcol : grow) * 16 + i16];
#pragma unroll
        for (int hh = 0; hh < 2; ++hh) { bf16* hp = U2 + (size_t)m * UPN + (2 * hh + hsel) * 192 + 128 + hf * 32 + i16;
            const float x1 = bf2f(hp[0]), x2 = bf2f(hp[16]); hp[0] = (bf16)f2bf(x1 * cs.x - x2 * cs.y); hp[16] = (bf16)f2bf(x2 * cs.x + x1 * cs.y); } }
}
__device__ __forceinline__ void fixup_phase(KP p, int l, int ntile, int wv) {
    asm volatile("" : "+s"(p));
    int tid_ = wv * 64 + lane_id_(); asm volatile("" : "+v"(tid_)); const int lane = tid_ & 63, wave = tid_ >> 6; const int gw = blockIdx.x * 8 + wave, NGW = gridDim.x * 8;
    bf16* HD = (bf16*)(p->ws + WS_HD); const float* Eg = (const float*)(p->ws + WS_EDGE); const float* Eu = (const float*)(p->ws + WS_EDGE + EDGE_EU);
    const float* cw = p->in[I_CW] + (size_t)l * 3 * FF; const float* cb = p->in[I_CB] + (size_t)l * FF;
    for (int it = gw; it < ntile * 2 * 22; it += NGW) { const int seg = it % 22, rw = (it / 22) & 1, pm = it / 44;
        const bool lat = pm < 64; const bool sstart = lat ? ((pm & 15) == 0) : true, send = lat ? ((pm & 15) == 15) : true;
        const int ch = seg * 256 + lane * 4;
        f32x4 gp, gc, gn, uu;
        if (rw == 0) { gp = sstart ? (f32x4){0.f, 0.f, 0.f, 0.f} : *(const f32x4*)(Eg + (size_t)((pm - 1) * 4 + 3) * FF + ch); gc = *(const f32x4*)(Eg + (size_t)(pm * 4 + 0) * FF + ch); gn = *(const f32x4*)(Eg + (size_t)(pm * 4 + 1) * FF + ch); uu = *(const f32x4*)(Eu + (size_t)(pm * 2 + 0) * FF + ch); }
        else { gp = *(const f32x4*)(Eg + (size_t)(pm * 4 + 2) * FF + ch); gc = *(const f32x4*)(Eg + (size_t)(pm * 4 + 3) * FF + ch); gn = send ? (f32x4){0.f, 0.f, 0.f, 0.f} : *(const f32x4*)(Eg + (size_t)((pm + 1) * 4 + 0) * FF + ch); uu = *(const f32x4*)(Eu + (size_t)(pm * 2 + 1) * FF + ch); }
        const f32x4 a = *(const f32x4*)(cw + ch) * gp + *(const f32x4*)(cw + FF + ch) * gc + *(const f32x4*)(cw + 2 * FF + ch) * gn + *(const f32x4*)(cb + ch);
        f32x4 h;
#pragma unroll
        for (int j = 0; j < 4; ++j) h[j] = a[j] / (1.0f + __expf(-a[j])) * uu[j];
        v2u w; w.x = pk2(h[0], h[1]); w.y = pk2(h[2], h[3]);
        *(v2u*)(HD + (size_t)(pm * 256 + (rw ? 255 : 0)) * FF + ch) = w; }
}
__device__ __forceinline__ void attn_phase(KP p, int l, unsigned char* lds, int wv) {
    asm volatile("" : "+s"(p));
    const bf16* P = (const bf16*)(p->ws + WS_P); const bf16* U2 = (const bf16*)(p->ws + WS_U2); bf16* MIX = (bf16*)(p->ws + WS_MIX);
    for (int v = blockIdx.x; v < 256; v += gridDim.x) {
        const int pair = v & 7, idx = v >> 3; const int nun = (l == 0 && v < 64) ? 5 : 4;
        for (int ui = 0; ui < nun; ++ui) {
            int b, h, qb, grp; bool cq = false;
            if (ui < 4) { b = pair >> 1; h = (pair & 1) * 2 + (idx >> 4); qb = idx & 15; grp = (ui == 0) ? 2 : (ui == 1) ? 3 : (ui == 2) ? 0 : 1; }
            else { b = v >> 4; grp = (v >> 2) & 3; h = v & 3; qb = 0; cq = true; }
            att::AttnArgs a; a.Q2 = nullptr; a.KR = nullptr; a.ldkr = INP; a.ldo = DM; a.has_sink = 0; a.sinkp = nullptr; a.rpb = nullptr;
            a.ctxrow0 = NLAT + b * CTX; a.qpos0 = qb * 256; a.qrow0 = cq ? NLAT + b * CTX : b * SEQ + qb * 256; a.wstart = 0; a.NT = cq ? 4 : 68;
            a.O = MIX + grp * 512 + h * 128;
            if (grp == 0) { a.Q = P + h * 128; a.K = P + 512 + h * 128; a.V = P + 1024 + h * 128; a.ldq = a.ldk = a.ldv = INP;
                if (!cq) { a.wstart = 64 * min(max(4 * qb - 4, 0), 52); a.NT = 16; a.rpb = p->in[I_RPB] + (size_t)(l * 4 + h) * 465; } }
            else if (grp == 1) { a.Q = P + 1536 + h * 128; a.K = P + 2048 + (h >> 1) * 128; a.V = P + 2304 + (h >> 1) * 128; a.ldq = a.ldk = a.ldv = INP;
                a.has_sink = 1; a.sinkp = p->in[I_SINK] + l * 4 + h;
                if (!cq) { a.wstart = min(max(256 * qb - 128, 0), SEQ - 512); a.NT = 12; } }
            else if (grp == 2) { a.Q = U2 + h * 192; a.Q2 = U2 + h * 192 + 128; a.K = U2 + 768 + h * 256; a.V = U2 + 768 + h * 256 + 128; a.KR = P + 3072; a.ldq = a.ldk = a.ldv = UPN; }
            else { a.Q = P + 3136 + h * 128; a.K = P + 3648 + (h >> 1) * 128; a.V = P + 3904 + (h >> 1) * 128; a.ldq = a.ldk = a.ldv = INP; }
            a.latrow0 = b * SEQ + a.wstart;
            if (grp == 2) att::attn_unit<0, true>(a, (char*)lds, wv);
            else if (grp == 0 && !cq) att::attn_unit<1, false>(a, (char*)lds, wv);
            else if (grp == 1 && !cq) att::attn_unit<2, false>(a, (char*)lds, wv);
            else att::attn_unit<0, false>(a, (char*)lds, wv);
        }
    }
}

__global__ void __launch_bounds__(512, 2) mk_fwd(Params p_unused) {
    extern __shared__ __attribute__((aligned(16))) unsigned char lds[];
    cg::grid_group grid = cg::this_grid();
    PG8_LAS unsigned char* ldsl = (PG8_LAS unsigned char*)lds;
    KP p = (KP)__builtin_amdgcn_kernarg_segment_ptr();
#define RELOAD() asm volatile("" : "+s"(p)); unsigned char* ws = p->ws
    const int G = gridDim.x, bx = blockIdx.x;
    const int wv = __builtin_amdgcn_readfirstlane((int)(threadIdx.x >> 6));
    volatile LAS unsigned* misc = (volatile LAS unsigned*)((LAS unsigned char*)lds + LDS_MISC_OFF);
    if (threadIdx.x < 16) misc[threadIdx.x] = 0u;
    __syncthreads();
    const XcdBarrier bar = xcd_barrier_post((unsigned*)(p->ws + WS_BAR), misc);
#define GSYNC() xcd_barrier(bar, wv)
    p0_phase(p, lds, wv);
    if (__builtin_expect(G == 0x7fffffff, 0)) grid.sync();
    GSYNC();
    modulate0_phase(p, wv, lds);
    GSYNC();
#pragma unroll 1
    for (int l = 0; l < 2; ++l) {
        const int M2 = (l == 0) ? MTOT : NLAT;
        { RELOAD(); pg8::Gemm g{(const bf16*)(ws + WS_H), (const bf16*)(ws + WS_WIN) + (size_t)l * INP * DM + (size_t)256 * DM, MTOT, INP - 512, DM, DM, DM}; pg8::StaticOrder S; S.init(MTOT, INP - 512, G, bx);
          pg8::EpiBf16 E{(bf16*)(ws + WS_P) + 256, INP}; pg8::gemm_phase<pg8::EpiBf16, pg8::StaticOrder, true, true>(ldsl, g, S, E, wv); }
        GSYNC();
        prep_phase(p, l, wv);
        GSYNC();
        { RELOAD(); constexpr int NBIG = 2 * (MTOT / 256);
          { pg8::Gemm g{(const bf16*)(ws + WS_H), (const bf16*)(ws + WS_WIN) + (size_t)l * INP * DM, MTOT, INP, DM, DM, DM}; pg8::ColOrder S{MTOT / 256, G, bx};
            pg8::EpiBf16 E{(bf16*)(ws + WS_P), INP}; pg8::gemm_phase<pg8::EpiBf16, pg8::ColOrder, true, true>(ldsl, g, S, E, wv); }
          { pg8::Gemm g{(const bf16*)(ws + WS_A2), (const bf16*)(ws + WS_WUP) + (size_t)l * UPN * UPK, MTOT, UPN, 256, UPK, UPK};
            pg8::UpOrder S{MTOT / 256, (G > NBIG + 8) ? G - NBIG : G, (G > NBIG + 8) ? bx - NBIG : bx};
            pg8::EpiUp E{(bf16*)(ws + WS_U2), UPN, (const float2*)(ws + WS_ROPE) + 64 * 32, NLAT}; pg8::gemm_phase<pg8::EpiUp, pg8::UpOrder, true, true>(ldsl, g, S, E, wv); } }
        GSYNC();
        attn_phase(p, l, lds, wv);
        GSYNC();
        { RELOAD(); pg8::Gemm g{(const bf16*)(ws + WS_MIX), (const bf16*)(ws + WS_WOUT) + (size_t)l * DM * DM, NLAT, DM, DM, DM, DM}; pg8::StaticOrder S; S.init(NLAT, DM, G, bx);
          pg8::EpiBf16 E{(bf16*)(ws + WS_Y), DM}; pg8::gemm_phase<pg8::EpiBf16, pg8::StaticOrder, true, true>(ldsl, g, S, E, wv);
          if (l == 0) { pg8::Gemm g2{(const bf16*)(ws + WS_MIX), (const bf16*)(ws + WS_WOUT) + (size_t)l * DM * DM, MTOT, DM, DM / 4, DM, DM}; pg8::SplitOrder S2{64, 4, 8, 4, G, bx};
            pg8::EpiSplit E2{(bf16*)(ws + WS_YP), DM}; pg8::gemm_phase<pg8::EpiSplit, pg8::SplitOrder, true, true>(ldsl, g2, S2, E2, wv); } }
        GSYNC();
        rowpass_phase(p, l, 1, M2, wv, lds);
        GSYNC();
        { RELOAD(); pg8::Gemm g{(const bf16*)(ws + WS_H), (const bf16*)(ws + WS_WGU) + (size_t)l * 2 * FF * DM, M2, 2 * FF, DM, DM, DM}; pg8::StaticOrder S; S.init(M2, 2 * FF, G, bx);
          pg8::EpiConv E{(bf16*)(ws + WS_HD), p->in[I_CW] + (size_t)l * 3 * FF, p->in[I_CB] + (size_t)l * FF, (float*)(ws + WS_EDGE), (float*)(ws + WS_EDGE + EDGE_EU), (PG8_LAS float*)(ldsl + LDS_X_OFF), (PG8_LAS float*)(ldsl + LDS_X_OFF + 4096 + 256)};
          pg8::gemm_phase<pg8::EpiConv, pg8::StaticOrder, true, true>(ldsl, g, S, E, wv); }
        GSYNC();
        fixup_phase(p, l, M2 / 256, wv);
        GSYNC();
        { RELOAD(); pg8::Gemm g{(const bf16*)(ws + WS_HD), (const bf16*)(ws + WS_WDN) + (size_t)l * DM * FF, NLAT, DM, FF, FF, FF}; pg8::StaticOrder S; S.init(NLAT, DM, G, bx);
          pg8::EpiBf16 E{(bf16*)(ws + WS_Y), DM}; pg8::gemm_phase<pg8::EpiBf16, pg8::StaticOrder, true, true>(ldsl, g, S, E, wv);
          if (l == 0) { pg8::Gemm g2{(const bf16*)(ws + WS_HD), (const bf16*)(ws + WS_WDN) + (size_t)l * DM * FF, MTOT, DM, FF / 4, FF, FF}; pg8::SplitOrder S2{64, 4, 8, 4, G, bx};
            pg8::EpiSplit E2{(bf16*)(ws + WS_YP), DM}; pg8::gemm_phase<pg8::EpiSplit, pg8::SplitOrder, true, true>(ldsl, g2, S2, E2, wv); } }
        GSYNC();
        rowpass_phase(p, l, 2, M2, wv, lds);
        if (l == 0) GSYNC();
    }
}

extern "C" void kernel_launch(void* const* d_in, const int* in_sizes, int n_in, void* d_out, int out_size, void* d_ws, size_t ws_size, hipStream_t stream) {
    static int grid = 0;
    if (grid == 0) {
        int dev = 0, cus = 0, per_cu = 0;
        (void)hipGetDevice(&dev);
        (void)hipDeviceGetAttribute(&cus, hipDeviceAttributeMultiprocessorCount, dev);
        (void)hipFuncSetAttribute((const void*)mk_fwd, hipFuncAttributeMaxDynamicSharedMemorySize, LDS_BYTES);
        (void)hipOccupancyMaxActiveBlocksPerMultiprocessor(&per_cu, (const void*)mk_fwd, 512, LDS_BYTES);
        if (per_cu < 1) per_cu = 1;
        grid = cus * per_cu;
        if (n_in != 25 || ws_size < WS_END || out_size != NLAT * DM) { fprintf(stderr, "kernel_launch: unexpected shapes (n_in %d out %d ws %zu)\n", n_in, out_size, ws_size); grid = -1; }
    }
    if (grid < 0) return;
    Params p{};
    for (int i = 0; i < 25; ++i) p.in[i] = (const float*)d_in[i];
    p.out = (float*)d_out; p.ws = (unsigned char*)d_ws;
    (void)hipMemsetAsync(d_ws, 0, CTL_ZERO_BYTES, stream);
    void* args[] = {&p};
    hipError_t e = hipLaunchCooperativeKernel((const void*)mk_fwd, dim3(grid), dim3(512), args, LDS_BYTES, stream);
    if (e != hipSuccess) fprintf(stderr, "cooperative launch failed: %s (grid %d)\n", hipGetErrorString(e), grid);
}
```
